# Optimizing an MI355X kernel written in HIP

```python
import jax, jax.numpy as jnp
from jax import lax
import numpy as np

D_MODEL = 1024
BATCH = 16
SEQ = 2048
DEPTH = 2

GRID_W = 64
HEAD_DIM = 64
A_HEADS = 8
A_KV_HEADS = 2
A_GROUPS = A_HEADS // A_KV_HEADS
Q_BLOCK = 128
ROPE_THETA = 10000.0
POOL_WINDOWS = (2, 4, 8, 16)
POOL_GROUP = 128
POOL_WIDTH = POOL_GROUP * len(POOL_WINDOWS)
C_HEADS = 8
NA_ROWS = 8
NA_COLS = 16
A_Q = A_HEADS * HEAD_DIM
A_KV = A_KV_HEADS * HEAD_DIM
C_W = C_HEADS * HEAD_DIM
N_BRANCH = 3
BRANCH_WIDTH = 512
IN_WIDTHS = (A_Q, A_KV, A_KV, POOL_WIDTH, C_W, C_W, C_W, N_BRANCH * D_MODEL)
D_IN = sum(IN_WIDTHS)
D_FF = 2816
CONV_W = 3
EPS = 1e-6

kernel_name = "hybrid_gated_axial_pool_natten_encoder"


def rmsnorm(x, g):
    xf = x.astype(jnp.float32)
    y = xf * lax.rsqrt(jnp.mean(xf * xf, axis=-1, keepdims=True) + EPS)
    return (y * g.astype(jnp.float32)).astype(x.dtype)


def rope_axis(x, pos):
    dim = x.shape[-1]
    half = dim // 2
    freqs = ROPE_THETA ** (-jnp.arange(0, dim, 2, dtype=jnp.float32) / dim)
    ang = pos.astype(jnp.float32)[:, None] * freqs[None, :]
    cos = jnp.cos(ang)[:, None, :]
    sin = jnp.sin(ang)[:, None, :]
    xf = x.astype(jnp.float32)
    x1, x2 = xf[..., :half], xf[..., half:]
    out = jnp.concatenate([x1 * cos - x2 * sin, x1 * sin + x2 * cos], axis=-1)
    return out.astype(x.dtype)


def rope_2d(x, row, col):
    half = x.shape[-1] // 2
    return jnp.concatenate([rope_axis(x[..., :half], row), rope_axis(x[..., half:], col)], axis=-1)


def global_axial_attention(q, k, v, gq, gk):
    B, S = q.shape[0], q.shape[1]
    t = jnp.arange(S)
    row, col = t // GRID_W, t % GRID_W
    q = rmsnorm(q.reshape(B, S, A_HEADS, HEAD_DIM), gq)
    k = rmsnorm(k.reshape(B, S, A_KV_HEADS, HEAD_DIM), gk)
    v = v.reshape(B, S, A_KV_HEADS, HEAD_DIM)
    q = rope_2d(q, row, col) * (HEAD_DIM ** -0.5)
    k = rope_2d(k, row, col)
    nb = S // Q_BLOCK
    qb = q.reshape(B, nb, Q_BLOCK, A_KV_HEADS, A_GROUPS, HEAD_DIM).transpose(1, 0, 2, 3, 4, 5)

    def block(qi):
        s = jnp.einsum('bqkgd,bskd->bkgqs', qi, k).astype(jnp.float32)
        p = jax.nn.softmax(s, axis=-1)
        return jnp.einsum('bkgqs,bskd->bqkgd', p.astype(v.dtype), v)

    o = lax.map(block, qb)
    return o.transpose(1, 0, 2, 3, 4, 5).reshape(B, S, A_Q)


def pool_mixer(u, w_pool, pool_scale):
    B, S = u.shape[0], u.shape[1]
    uf = u.astype(jnp.float32)
    cs = jnp.concatenate([jnp.zeros((B, 1, POOL_WIDTH), jnp.float32), jnp.cumsum(uf, axis=1)], axis=1)
    t = jnp.arange(S)
    outs = []
    for g, w in enumerate(POOL_WINDOWS):
        sl = slice(g * POOL_GROUP, (g + 1) * POOL_GROUP)
        lo = jnp.clip(t - w // 2, 0, S)
        hi = jnp.clip(t + w - w // 2, 0, S)
        csg = cs[..., sl]
        mean = (csg[:, hi] - csg[:, lo]) / (hi - lo).astype(jnp.float32)[None, :, None]
        diff = (mean - uf[..., sl]).astype(u.dtype)
        outs.append(jnp.einsum('bsc,cd->bsd', diff, w_pool[g]))
    return jnp.concatenate(outs, axis=-1) * pool_scale


def neighbourhood_attention(q, k, v, rpb):
    B, S = q.shape[0], q.shape[1]
    rows = S // GRID_W
    win_r = min(NA_ROWS, rows)
    qg = q.reshape(B, rows, GRID_W, C_HEADS, HEAD_DIM) * (HEAD_DIM ** -0.5)
    kg = k.reshape(B, rows, GRID_W, C_HEADS, HEAD_DIM)
    vg = v.reshape(B, rows, GRID_W, C_HEADS, HEAD_DIM)
    col = jnp.arange(GRID_W)
    col_start = jnp.clip(col - NA_COLS // 2, 0, GRID_W - NA_COLS)
    col_idx = col_start[:, None] + jnp.arange(NA_COLS)[None, :]
    dc = col_idx - col[:, None] + (NA_COLS - 1)

    def row_block(args):
        r, q_row = args
        rs = jnp.clip(r - win_r // 2, 0, rows - win_r)
        k_rows = lax.dynamic_slice_in_dim(kg, rs, win_r, axis=1)
        v_rows = lax.dynamic_slice_in_dim(vg, rs, win_r, axis=1)
        k_nb = k_rows[:, :, col_idx]
        v_nb = v_rows[:, :, col_idx]
        dr = rs + jnp.arange(win_r) - r + (NA_ROWS - 1)
        bias = rpb[:, dr[None, :, None], dc[:, None, :]]
        s = jnp.einsum('bqhd,brqjhd->bhqrj', q_row, k_nb).astype(jnp.float32)
        s = s + bias.astype(jnp.float32)[None]
        p = jax.nn.softmax(s.reshape(B, C_HEADS, GRID_W, win_r * NA_COLS), axis=-1)
        p = p.reshape(B, C_HEADS, GRID_W, win_r, NA_COLS).astype(v.dtype)
        return jnp.einsum('bhqrj,brqjhd->bqhd', p, v_nb)

    o = lax.map(row_block, (jnp.arange(rows), qg.transpose(1, 0, 2, 3, 4)))
    return o.transpose(1, 0, 2, 3, 4).reshape(B, S, C_W)


def conv_gated_mlp(h, w_up, conv_w, conv_b, w_down):
    up = jnp.einsum('bsd,df->bsf', h, w_up)
    pad = jnp.pad(up, ((0, 0), (1, 1), (0, 0)))
    up = pad[:, :-2] * conv_w[0] + pad[:, 1:-1] * conv_w[1] + pad[:, 2:] * conv_w[2] + conv_b
    val, gate = up[..., :D_FF], up[..., D_FF:]
    return jnp.einsum('bsf,fd->bsd', jax.nn.gelu(gate, approximate=True) * val, w_down)


def setup_inputs(seed: int = 0) -> dict:
    key = jax.random.key(seed)
    ks = jax.random.split(key, 20)
    n = lambda k, shape, s: jax.random.normal(k, shape, jnp.float32) * s
    L, D = DEPTH, D_MODEL
    return {
        "x": n(ks[0], (BATCH, SEQ, D), 1.0),
        "norm_mix_pre": 1.0 + n(ks[1], (L, D), 0.1),
        "norm_mix_post": 1.0 + n(ks[2], (L, D), 0.1),
        "norm_ffn_pre": 1.0 + n(ks[3], (L, D), 0.1),
        "norm_ffn_post": 1.0 + n(ks[4], (L, D), 0.1),
        "w_in": n(ks[5], (L, D, D_IN), D ** -0.5),
        "b_gate": n(ks[6], (L, N_BRANCH * D), 0.1),
        "qk_norm_q": 1.0 + n(ks[7], (L, HEAD_DIM), 0.1),
        "qk_norm_k": 1.0 + n(ks[8], (L, HEAD_DIM), 0.1),
        "w_pool": n(ks[9], (L, len(POOL_WINDOWS), POOL_GROUP, POOL_GROUP), POOL_GROUP ** -0.5),
        "pool_scale": 1.0 + n(ks[10], (L, POOL_WIDTH), 0.1),
        "rpb": n(ks[11], (L, C_HEADS, 2 * NA_ROWS - 1, 2 * NA_COLS - 1), 0.5),
        "w_branch": n(ks[12], (L, N_BRANCH, BRANCH_WIDTH, D), BRANCH_WIDTH ** -0.5),
        "w_out": n(ks[13], (L, D, D), D ** -0.5),
        "w_up": n(ks[14], (L, D, 2 * D_FF), D ** -0.5),
        "conv_w": n(ks[15], (L, CONV_W, 2 * D_FF), CONV_W ** -0.5),
        "conv_b": n(ks[16], (L, 2 * D_FF), 0.01),
        "w_down": n(ks[17], (L, D_FF, D), D_FF ** -0.5),
    }


def reference(x, norm_mix_pre, norm_mix_post, norm_ffn_pre, norm_ffn_post, w_in, b_gate,
              qk_norm_q, qk_norm_k, w_pool, pool_scale, rpb, w_branch, w_out,
              w_up, conv_w, conv_b, w_down):
    B, S = x.shape[0], x.shape[1]
    splits = [int(s) for s in np.cumsum(IN_WIDTHS)[:-1]]
    for l in range(DEPTH):
        h = rmsnorm(x, norm_mix_pre[l])
        proj = jnp.einsum('bsd,de->bse', h, w_in[l])
        qa, ka, va, pu, qc, kc, vc, gl = jnp.split(proj, splits, axis=-1)
        ya = global_axial_attention(qa, ka, va, qk_norm_q[l], qk_norm_k[l])
        yb = pool_mixer(pu, w_pool[l], pool_scale[l])
        yc = neighbourhood_attention(qc, kc, vc, rpb[l])
        ys = jnp.stack([ya, yb, yc], axis=2)
        z = jnp.einsum('bsnc,ncd->bsnd', ys, w_branch[l])
        gates = jax.nn.sigmoid(gl + b_gate[l]).reshape(B, S, N_BRANCH, D_MODEL)
        merged = jnp.sum(gates * z, axis=2)
        mix = jnp.einsum('bsd,de->bse', merged, w_out[l])
        x = x + rmsnorm(mix, norm_mix_post[l])
        h = rmsnorm(x, norm_ffn_pre[l])
        f = conv_gated_mlp(h, w_up[l], conv_w[l], conv_b[l], w_down[l])
        x = x + rmsnorm(f, norm_ffn_post[l])
    return x
```

```cpp
#include <hip/hip_runtime.h>
#include <hip/hip_cooperative_groups.h>
#include <cstdio>
#include <cstdint>
namespace cg = cooperative_groups;

namespace pg8 {
#define PG8_LAS __attribute__((address_space(3)))
typedef unsigned short bf16_t;
typedef short bf16x8 __attribute__((ext_vector_type(8)));
typedef float f32x4 __attribute__((ext_vector_type(4)));
typedef unsigned u32x4 __attribute__((ext_vector_type(4)));
constexpr int BM = 256, BK = 64, HALF = 128, HTB = HALF * BK * 2, STAGE_BYTES = 8 * HTB, NXCD = 8, WGM = 8;

__host__ __device__ __forceinline__ int lds_byte(int r, int c) { const int st = (r >> 4) * 2 + (c >> 5), rr = r & 15, cc = c & 31, ob = rr * 64 + cc * 2; return st * 1024 + (ob ^ (((ob >> 9) & 1) << 5)); }
__host__ __device__ __forceinline__ void stage_rc(int b, int& R, int& C) { const int st = b / 1024, sb = b % 1024, swz = sb ^ (((sb >> 9) & 1) << 5); R = (st >> 1) * 16 + swz / 64; C = (st & 1) * 32 + (swz % 64) / 2; }
__host__ __device__ __forceinline__ int perm32(int rho) { const int n = rho >> 4, i = rho & 15; return 8 * (i >> 2) + 4 * n + (i & 3); }

struct Unit { int pm, pn, n; size_t aoff, boff; };
struct Gemm { const bf16_t* A; const bf16_t* Bt; int lda, ldb, K; };

__device__ __forceinline__ void tile_of(int L, int nM, int nN, int& pm, int& pn) {
    const int nwg = nM * nN; int wgid = L; { const int q = nwg / NXCD, r = nwg % NXCD, xcd = wgid % NXCD, off = wgid / NXCD; wgid = (xcd < r ? xcd * (q + 1) : r * (q + 1) + (xcd - r) * q) + off; }
    const int nig = WGM * nN, gid = wgid / nig, fm = gid * WGM, gsz = (nM - fm) < WGM ? (nM - fm) : WGM;
    pm = fm + ((wgid % nig) % gsz); pn = (wgid % nig) / gsz;
}
struct StdSched {
    int nM, nN, G, c; size_t astep, bstep;
    __device__ __forceinline__ bool next(int i, Unit& u) const {
        const long L = (long)i * G + c; if (L >= (long)nM * nN) return false;
        tile_of((int)L, nM, nN, u.pm, u.pn); u.n = 0; u.aoff = (size_t)u.pm * astep; u.boff = (size_t)u.pn * bstep; return true;
    }
    __device__ __forceinline__ void a_ready(const Unit&) const {}
    __device__ __forceinline__ void done(const Unit&) const {}
};
__device__ __forceinline__ unsigned cvt_pk_bf16(float lo, float hi) { unsigned r; asm volatile("v_cvt_pk_bf16_f32 %0, %1, %2" : "=v"(r) : "v"(lo), "v"(hi)); return r; }
template <class Epi, class Sched, bool ALIGN_EPI = false, bool SP2 = false>
__device__ __forceinline__ void gemm_phase(PG8_LAS unsigned char* lds, const Gemm g, const Sched& S, const Epi& E) {
    int tid_ = threadIdx.x; asm volatile("" : "+v"(tid_));
    const int tid = tid_, wid = __builtin_amdgcn_readfirstlane(tid >> 6), lane = tid & 63, wr = wid >> 2, wc = wid & 3, fr = lane & 15, fq = lane >> 4;
    const int K = g.K, nt = K / BK;
    unsigned voffA[2], voffB[2];
#pragma unroll
    for (int i = 0; i < 2; ++i) { int R, C; stage_rc(tid * 16 + i * 8192, R, C); const int Rb = Epi::PERM ? ((R & ~31) + perm32(R & 31)) : R;
        voffA[i] = (unsigned)(R * g.lda + C) * 2u; voffB[i] = (unsigned)(Rb * g.ldb + C) * 2u; }
    const size_t kstep = (size_t)(BK * 2);
    const size_t hstepA = (size_t)HALF * g.lda * 2, hstepB = (size_t)HALF * g.ldb * 2;
    const unsigned ldsw = (unsigned)wid * 1024u;
    const int aoff = lds_byte(wr * 64 + fr, fq * 8), boff = lds_byte(wc * 32 + fr, fq * 8);
#define PG8_SA(b, h) (((b) * 2 + (h)) * HTB)
#define PG8_SB(b, h) ((4 + (b) * 2 + (h)) * HTB)
#define PG8_STAGE(bufoff, gbase, voff) do { _Pragma("unroll") for (int _i = 0; _i < 2; ++_i) \
        __builtin_amdgcn_global_load_lds((const unsigned*)((const char*)(gbase) + (voff)[_i]), (PG8_LAS unsigned*)(lds + (bufoff) + ldsw + _i * 8192), 16, 0, 0); } while (0)
#define PG8_LDA(dst, b, h) do { _Pragma("unroll") for (int m = 0; m < 4; ++m) _Pragma("unroll") for (int k = 0; k < 2; ++k) dst[m][k] = *(const PG8_LAS bf16x8*)(lds + PG8_SA(b, h) + aoff + m * 2048 + k * 1024); } while (0)
#define PG8_LDB(dst, b, h) do { _Pragma("unroll") for (int n = 0; n < 2; ++n) _Pragma("unroll") for (int k = 0; k < 2; ++k) dst[n][k] = *(const PG8_LAS bf16x8*)(lds + PG8_SB(b, h) + boff + n * 2048 + k * 1024); } while (0)
#define PG8_MMA(ai, bj, At, Bt) do { __builtin_amdgcn_s_setprio(1); _Pragma("unroll") for (int m = 0; m < 4; ++m) _Pragma("unroll") for (int n = 0; n < 2; ++n) _Pragma("unroll") for (int k = 0; k < 2; ++k) \
        acc[ai][bj][m][n] = __builtin_amdgcn_mfma_f32_16x16x32_bf16(Bt[n][k], At[m][k], acc[ai][bj][m][n], 0, 0, 0); __builtin_amdgcn_s_setprio(0); } while (0)
#define PG8_WAIT_V(n) asm volatile("s_waitcnt vmcnt(" #n ")" ::: "memory")
#define PG8_WAIT_L(n) asm volatile("s_waitcnt lgkmcnt(" #n ")" ::: "memory")
#define PG8_BAR __builtin_amdgcn_s_barrier()
#define PG8_SCHED __builtin_amdgcn_sched_barrier(0)
    Unit cur, nxt; int ui = 0;
    if (!S.next(0, cur)) return;
    f32x4 acc[2][2][4][2];
#pragma unroll
    for (int a = 0; a < 2; ++a)
#pragma unroll
        for (int b = 0; b < 2; ++b)
#pragma unroll
            for (int m = 0; m < 4; ++m)
#pragma unroll
                for (int n = 0; n < 2; ++n) acc[a][b][m][n] = (f32x4){0.f, 0.f, 0.f, 0.f};
    bf16x8 At[4][2], B0[2][2], B1[2][2];
    const char* cA = (const char*)g.A + cur.aoff; const char* cB = (const char*)g.Bt + cur.boff;
    S.a_ready(cur);
    if constexpr (SP2) {
        PG8_STAGE(PG8_SB(0, 0), cB, voffB); PG8_STAGE(PG8_SB(0, 1), cB + hstepB, voffB); PG8_STAGE(PG8_SA(0, 0), cA, voffA); PG8_STAGE(PG8_SA(0, 1), cA + hstepA, voffA);
        if (wr == 1) PG8_BAR;
        PG8_WAIT_V(2); PG8_BAR;
        PG8_STAGE(PG8_SB(1, 0), cB + kstep, voffB); PG8_STAGE(PG8_SA(1, 0), cA + kstep, voffA); PG8_STAGE(PG8_SB(1, 1), cB + hstepB + kstep, voffB);
        PG8_WAIT_V(6); PG8_BAR;
    } else {
        PG8_STAGE(PG8_SB(0, 0), cB, voffB); PG8_STAGE(PG8_SA(0, 0), cA, voffA); PG8_STAGE(PG8_SB(0, 1), cB + hstepB, voffB); PG8_STAGE(PG8_SA(0, 1), cA + hstepA, voffA);
        if (wr == 1) PG8_BAR;
        PG8_WAIT_V(4); PG8_BAR;
        PG8_STAGE(PG8_SB(1, 0), cB + kstep, voffB); PG8_STAGE(PG8_SA(1, 0), cA + kstep, voffA); PG8_STAGE(PG8_SB(1, 1), cB + hstepB + kstep, voffB);
        PG8_WAIT_V(6); PG8_BAR;
    }
    for (;;) {
        const bool has_next = S.next(ui + 1, nxt);
        const char* nA = has_next ? (const char*)g.A + nxt.aoff : cA; const char* nB = has_next ? (const char*)g.Bt + nxt.boff : cB;
        for (int t = 0; t < nt; t += 2) {
            const bool last = (t == nt - 2);
            const char* a1 = cA + (size_t)(t + 1) * kstep;
            const char* a2 = last ? nA : cA + (size_t)(t + 2) * kstep; const char* b2 = last ? nB : cB + (size_t)(t + 2) * kstep;
            const char* a3 = a2 + kstep; const char* b3 = b2 + kstep;
            if (last && has_next) S.a_ready(nxt);
            if constexpr (SP2) {
            PG8_LDB(B0, 0, 0); PG8_LDB(B1, 0, 1); PG8_SCHED; PG8_LDA(At, 0, 0); PG8_STAGE(PG8_SA(1, 1), a1 + hstepA, voffA);
            PG8_WAIT_V(8); PG8_WAIT_L(0); PG8_BAR; PG8_MMA(0, 0, At, B0); PG8_MMA(0, 1, At, B1); PG8_BAR; PG8_SCHED;
            PG8_LDA(At, 0, 1); PG8_STAGE(PG8_SB(0, 0), b2, voffB); PG8_STAGE(PG8_SB(0, 1), b2 + hstepB, voffB); PG8_STAGE(PG8_SA(0, 0), a2, voffA);
            PG8_WAIT_V(8); PG8_WAIT_L(0); PG8_BAR; PG8_MMA(1, 0, At, B0); PG8_MMA(1, 1, At, B1); PG8_BAR; PG8_SCHED;
            PG8_LDB(B0, 1, 0); PG8_LDB(B1, 1, 1); PG8_SCHED; PG8_LDA(At, 1, 0); PG8_STAGE(PG8_SA(0, 1), a2 + hstepA, voffA);
            PG8_WAIT_V(8); PG8_WAIT_L(0); PG8_BAR; PG8_MMA(0, 0, At, B0); PG8_MMA(0, 1, At, B1); PG8_BAR; PG8_SCHED;
            PG8_LDA(At, 1, 1); PG8_STAGE(PG8_SB(1, 0), b3, voffB); PG8_STAGE(PG8_SB(1, 1), b3 + hstepB, voffB); PG8_STAGE(PG8_SA(1, 0), a3, voffA);
            PG8_WAIT_V(8); PG8_WAIT_L(0); PG8_BAR; PG8_MMA(1, 0, At, B0); PG8_MMA(1, 1, At, B1); PG8_BAR; PG8_SCHED;
            } else {
            PG8_LDB(B0, 0, 0); PG8_SCHED; PG8_LDA(At, 0, 0); PG8_STAGE(PG8_SA(1, 1), a1 + hstepA, voffA);
            PG8_WAIT_L(8); PG8_BAR; PG8_WAIT_L(0); PG8_MMA(0, 0, At, B0); PG8_BAR; PG8_SCHED;
            PG8_LDB(B1, 0, 1); PG8_STAGE(PG8_SB(0, 0), b2, voffB);
            PG8_BAR; PG8_WAIT_L(0); PG8_MMA(0, 1, At, B1); PG8_BAR;
            PG8_LDA(At, 0, 1); PG8_STAGE(PG8_SA(0, 0), a2, voffA);
            PG8_BAR; PG8_WAIT_L(0); PG8_MMA(1, 0, At, B0); PG8_BAR; PG8_SCHED;
            PG8_STAGE(PG8_SB(0, 1), b2 + hstepB, voffB);
            PG8_WAIT_V(6); PG8_BAR; PG8_MMA(1, 1, At, B1); PG8_BAR;
            PG8_LDB(B0, 1, 0); PG8_SCHED; PG8_LDA(At, 1, 0); PG8_STAGE(PG8_SA(0, 1), a2 + hstepA, voffA);
            PG8_WAIT_L(8); PG8_BAR; PG8_WAIT_L(0); PG8_MMA(0, 0, At, B0); PG8_BAR; PG8_SCHED;
            PG8_LDB(B1, 1, 1); PG8_STAGE(PG8_SB(1, 0), b3, voffB);
            PG8_BAR; PG8_WAIT_L(0); PG8_MMA(0, 1, At, B1); PG8_BAR;
            PG8_LDA(At, 1, 1); PG8_STAGE(PG8_SA(1, 0), a3, voffA);
            PG8_BAR; PG8_WAIT_L(0); PG8_MMA(1, 0, At, B0); PG8_BAR; PG8_SCHED;
            PG8_STAGE(PG8_SB(1, 1), b3 + hstepB, voffB);
            PG8_WAIT_V(6); PG8_BAR; PG8_MMA(1, 1, At, B1); PG8_BAR;
            }
        }
        if constexpr (ALIGN_EPI) { if (wr == 0) PG8_BAR; }
        if constexpr (!Epi::AFTER_DRAIN) { E(acc, cur, wr, wc, fr, fq); S.done(cur); }
        if (!has_next) break;
#pragma unroll
        for (int a = 0; a < 2; ++a)
#pragma unroll
            for (int b = 0; b < 2; ++b)
#pragma unroll
                for (int m = 0; m < 4; ++m)
#pragma unroll
                    for (int n = 0; n < 2; ++n) acc[a][b][m][n] = (f32x4){0.f, 0.f, 0.f, 0.f};
        cur = nxt; cA = nA; cB = nB; ++ui;
        if constexpr (ALIGN_EPI) { if (wr == 1) PG8_BAR; }
    }
    PG8_WAIT_V(0);
    if constexpr (!ALIGN_EPI) { if (wr == 0) PG8_BAR; }
    PG8_BAR;
    if constexpr (Epi::AFTER_DRAIN) { E.fused(acc, cur, wr, wc, fr, fq, lds, wid, lane); S.done(cur); }
#undef PG8_SA
#undef PG8_SB
#undef PG8_STAGE
#undef PG8_LDA
#undef PG8_LDB
#undef PG8_MMA
#undef PG8_WAIT_V
#undef PG8_WAIT_L
#undef PG8_BAR
#undef PG8_SCHED
}
}

typedef unsigned short bf16_t;
typedef short bf16x8 __attribute__((ext_vector_type(8)));
typedef float f32x4 __attribute__((ext_vector_type(4)));
typedef float f32x16 __attribute__((ext_vector_type(16)));
typedef unsigned u32x4 __attribute__((ext_vector_type(4)));
typedef unsigned u32x2 __attribute__((ext_vector_type(2)));
#define LAS __attribute__((address_space(3)))

constexpr int NTOK = 32768, DM = 1024, SEQ = 2048, DIN = 5888, DFF = 2816, DUP = 5632;
constexpr int C_KA = 512, C_VA = 640, C_POOL = 768, C_QC = 1280, C_KC = 1792, C_VC = 2304, C_GATE = 2816;
constexpr float EPS = 1e-6f, LOG2E = 1.4426950408889634f;
constexpr size_t MiB = (size_t)1 << 20;
constexpr size_t WS_W = 1 * MiB;
constexpr size_t WS_XN = 68 * MiB;
constexpr size_t WS_BIG = 132 * MiB;
constexpr size_t WS_VAT = 500 * MiB;
constexpr size_t WS_END = 508 * MiB;
constexpr size_t OW_IN = 0, OW_BR = 12058624, OW_OUT = 15204352, OW_UP = 17301504, OW_DN = 28835840, OW_POOL = 34603008;
constexpr int LDS_BYTES = 131072 + 1024;

__device__ __forceinline__ float bf2f(unsigned v) { return __uint_as_float(v << 16); }
__device__ __forceinline__ float bflo(unsigned u) { return __uint_as_float(u << 16); }
__device__ __forceinline__ float bfhi(unsigned u) { return __uint_as_float(u & 0xffff0000u); }
__device__ __forceinline__ unsigned pk2(float lo, float hi) { return pg8::cvt_pk_bf16(lo, hi); }
__device__ __forceinline__ float wave_sum(float v) {
#pragma unroll
    for (int o = 1; o < 64; o <<= 1) v += __shfl_xor(v, o);
    return v;
}
__device__ __forceinline__ float wave_max(float v) {
#pragma unroll
    for (int o = 1; o < 64; o <<= 1) v = fmaxf(v, __shfl_xor(v, o));
    return v;
}

struct EpiPlain {
    static constexpr bool PERM = true, AFTER_DRAIN = false;
    bf16_t* O; int ldc;
    __device__ __forceinline__ void operator()(const f32x4 (&acc)[2][2][4][2], const pg8::Unit& u, int wr, int wc, int fr, int fq) const {
        const int row0 = u.pm * 256 + wr * 64 + fr, col0 = u.pn * 256 + wc * 32 + 8 * fq;
#pragma unroll
        for (int ai = 0; ai < 2; ++ai)
#pragma unroll
            for (int m = 0; m < 4; ++m) { bf16_t* rowp = O + (size_t)(row0 + ai * 128 + m * 16) * ldc + col0;
#pragma unroll
                for (int bj = 0; bj < 2; ++bj) { const f32x4 v0 = acc[ai][bj][m][0], v1 = acc[ai][bj][m][1];
                    u32x4 w; w.x = pk2(v0[0], v0[1]); w.y = pk2(v0[2], v0[3]); w.z = pk2(v1[0], v1[1]); w.w = pk2(v1[2], v1[3]);
                    *(u32x4*)(rowp + bj * 128) = w; } }
    }
};
struct EpiProj {
    static constexpr bool PERM = true, AFTER_DRAIN = false;
    bf16_t* O; const float* bgate;
    __device__ __forceinline__ void operator()(const f32x4 (&acc)[2][2][4][2], const pg8::Unit& u, int wr, int wc, int fr, int fq) const {
        const int row0 = u.pm * 256 + wr * 64 + fr, col0 = u.pn * 256 + wc * 32 + 8 * fq;
        const bool gate = (u.pn >= 11);
        f32x4 bv[2][2];
#pragma unroll
        for (int bj = 0; bj < 2; ++bj)
#pragma unroll
            for (int n = 0; n < 2; ++n) bv[bj][n] = gate ? *(const f32x4*)(bgate + (col0 - C_GATE) + bj * 128 + 4 * n) : (f32x4){0.f, 0.f, 0.f, 0.f};
#pragma unroll
        for (int ai = 0; ai < 2; ++ai)
#pragma unroll
            for (int m = 0; m < 4; ++m) { bf16_t* rowp = O + (size_t)(row0 + ai * 128 + m * 16) * DIN + col0;
#pragma unroll
                for (int bj = 0; bj < 2; ++bj) { f32x4 v0 = acc[ai][bj][m][0], v1 = acc[ai][bj][m][1];
                    if (gate) {
#pragma unroll
                        for (int j = 0; j < 4; ++j) { v0[j] = __builtin_amdgcn_rcpf(1.f + __expf(-(v0[j] + bv[bj][0][j]))); v1[j] = __builtin_amdgcn_rcpf(1.f + __expf(-(v1[j] + bv[bj][1][j]))); }
                    }
                    u32x4 w; w.x = pk2(v0[0], v0[1]); w.y = pk2(v0[2], v0[3]); w.z = pk2(v1[0], v1[1]); w.w = pk2(v1[2], v1[3]);
                    *(u32x4*)(rowp + bj * 128) = w; } }
    }
};
struct EpiBranch {
    static constexpr bool PERM = true, AFTER_DRAIN = false;
    const bf16_t* P; bf16_t* MG;
    __device__ __forceinline__ void operator()(const f32x4 (&acc)[2][2][4][2], const pg8::Unit& u, int wr, int wc, int fr, int fq) const {
        const int row0 = u.pm * 256 + wr * 64 + fr, col0 = u.pn * 256 + wc * 32 + 8 * fq;
#pragma unroll
        for (int ai = 0; ai < 2; ++ai)
#pragma unroll
            for (int m = 0; m < 4; ++m) { const size_t r = (size_t)(row0 + ai * 128 + m * 16);
#pragma unroll
                for (int bj = 0; bj < 2; ++bj) { const int c = col0 + bj * 128;
                    const u32x4 gt = *(const u32x4*)(P + r * DIN + C_GATE + u.n * 1024 + c);
                    const f32x4 a0 = acc[ai][bj][m][0], a1 = acc[ai][bj][m][1];
                    float v[8];
                    v[0] = a0[0] * bflo(gt.x); v[1] = a0[1] * bfhi(gt.x); v[2] = a0[2] * bflo(gt.y); v[3] = a0[3] * bfhi(gt.y);
                    v[4] = a1[0] * bflo(gt.z); v[5] = a1[1] * bfhi(gt.z); v[6] = a1[2] * bflo(gt.w); v[7] = a1[3] * bfhi(gt.w);
                    bf16_t* mp = MG + r * DM + c;
                    if (u.n > 0) { const u32x4 od = *(const u32x4*)mp;
                        v[0] += bflo(od.x); v[1] += bfhi(od.x); v[2] += bflo(od.y); v[3] += bfhi(od.y); v[4] += bflo(od.z); v[5] += bfhi(od.z); v[6] += bflo(od.w); v[7] += bfhi(od.w); }
                    u32x4 w; w.x = pk2(v[0], v[1]); w.y = pk2(v[2], v[3]); w.z = pk2(v[4], v[5]); w.w = pk2(v[6], v[7]);
                    *(u32x4*)mp = w; } }
    }
};
struct BranchSched {
    int G, c;
    __device__ __forceinline__ bool next(int i, pg8::Unit& u) const {
        const int t = i / 3, n = i - 3 * t; const long L = (long)t * G + c; if (L >= 512) return false;
        pg8::tile_of((int)L, 128, 4, u.pm, u.pn); u.n = n;
        const int colA = (n == 0) ? 0 : (n == 1 ? C_POOL : C_QC);
        u.aoff = ((size_t)u.pm * 256 * DIN + colA) * 2; u.boff = ((size_t)(n * 1024 + u.pn * 256) * 512) * 2; return true;
    }
    __device__ __forceinline__ void a_ready(const pg8::Unit&) const {}
    __device__ __forceinline__ void done(const pg8::Unit&) const {}
};
struct EpiUp {
    static constexpr bool PERM = true, AFTER_DRAIN = false;
    bf16_t* O; bf16_t* HALO;
    __device__ __forceinline__ void operator()(const f32x4 (&acc)[2][2][4][2], const pg8::Unit& u, int wr, int wc, int fr, int fq) const {
        const int row0 = u.pm * 256 + wr * 64 + fr, col0 = u.pn * 256 + wc * 32 + 8 * fq;
        const bool val = (u.pn < 11);
#pragma unroll
        for (int ai = 0; ai < 2; ++ai)
#pragma unroll
            for (int m = 0; m < 4; ++m) { bf16_t* rowp = O + (size_t)(row0 + ai * 128 + m * 16) * DUP + col0;
#pragma unroll
                for (int bj = 0; bj < 2; ++bj) { const f32x4 v0 = acc[ai][bj][m][0], v1 = acc[ai][bj][m][1];
                    u32x4 w; w.x = pk2(v0[0], v0[1]); w.y = pk2(v0[2], v0[3]); w.z = pk2(v1[0], v1[1]); w.w = pk2(v1[2], v1[3]);
                    *(u32x4*)(rowp + bj * 128) = w;
                    if (val && m == 0 && fr == 0)  *(u32x4*)(HALO + ((size_t)((u.pm * 4 + ai * 2 + wr) * 2 + 0)) * DFF + col0 + bj * 128) = w;
                    if (val && m == 3 && fr == 15) *(u32x4*)(HALO + ((size_t)((u.pm * 4 + ai * 2 + wr) * 2 + 1)) * DFF + col0 + bj * 128) = w; } }
    }
};

struct Ctx {
    const float* in[18]; float* out; unsigned char* ws; unsigned char* lds; int G;
};

__device__ __forceinline__ void transpose_item(const float* W, int K, int N, bf16_t* WT, float* scr, int item, int lane) {
    const int nblk = N / 32, kb = item / nblk, nb = item % nblk, k0 = 64 * kb, n0 = 32 * nb;
#pragma unroll 8
    for (int i = 0; i < 32; ++i) { const int kk = 2 * i + (lane >> 5); scr[kk * 33 + (lane & 31)] = W[(size_t)(k0 + kk) * N + n0 + (lane & 31)]; }
    asm volatile("s_waitcnt lgkmcnt(0)" ::: "memory");
    const int c = lane & 7;
#pragma unroll
    for (int j = 0; j < 4; ++j) { const int n = (lane >> 3) + 8 * j; const float* s = scr + (8 * c) * 33 + n;
        u32x4 o; o.x = pk2(s[0 * 33], s[1 * 33]); o.y = pk2(s[2 * 33], s[3 * 33]); o.z = pk2(s[4 * 33], s[5 * 33]); o.w = pk2(s[6 * 33], s[7 * 33]);
        *(u32x4*)(WT + (size_t)(n0 + n) * K + k0 + 8 * c) = o; }
    asm volatile("s_waitcnt lgkmcnt(0)" ::: "memory");
}
__device__ __forceinline__ void norm_row(const float* xrow, const float* g, bf16_t* orow, int lane) {
    const f32x4* xr = (const f32x4*)xrow + lane; const f32x4* gr = (const f32x4*)g + lane;
    f32x4 v[4]; float s = 0.f;
#pragma unroll
    for (int j = 0; j < 4; ++j) { v[j] = xr[64 * j]; s += (v[j].x * v[j].x + v[j].y * v[j].y) + (v[j].z * v[j].z + v[j].w * v[j].w); }
    const float rs = rsqrtf(wave_sum(s) * (1.f / DM) + EPS);
    u32x2* o8 = (u32x2*)orow + lane;
#pragma unroll
    for (int j = 0; j < 4; ++j) { const f32x4 gg = gr[64 * j]; u32x2 w; w.x = pk2(v[j].x * rs * gg.x, v[j].y * rs * gg.y); w.y = pk2(v[j].z * rs * gg.z, v[j].w * rs * gg.w); o8[64 * j] = w; }
}
__device__ __forceinline__ void resnorm_row(const bf16_t* src, const float* xin, const float* gpost, float* xo, const float* gnext, bf16_t* xn, int lane) {
    const u32x2* sr = (const u32x2*)src + lane; const f32x4* xr = (const f32x4*)xin + lane; const f32x4* gp = (const f32x4*)gpost + lane;
    f32x4 v[4]; float s = 0.f;
#pragma unroll
    for (int j = 0; j < 4; ++j) { const u32x2 w = sr[64 * j]; v[j] = (f32x4){bflo(w.x), bfhi(w.x), bflo(w.y), bfhi(w.y)}; s += (v[j].x * v[j].x + v[j].y * v[j].y) + (v[j].z * v[j].z + v[j].w * v[j].w); }
    const float rs = rsqrtf(wave_sum(s) * (1.f / DM) + EPS);
    float s2 = 0.f;
#pragma unroll
    for (int j = 0; j < 4; ++j) { const f32x4 gg = gp[64 * j], xx = xr[64 * j]; v[j] = xx + v[j] * rs * gg; s2 += (v[j].x * v[j].x + v[j].y * v[j].y) + (v[j].z * v[j].z + v[j].w * v[j].w); }
    f32x4* xw = (f32x4*)xo + lane;
#pragma unroll
    for (int j = 0; j < 4; ++j) xw[64 * j] = v[j];
    if (gnext) {
        const float rs2 = rsqrtf(wave_sum(s2) * (1.f / DM) + EPS);
        const f32x4* gn = (const f32x4*)gnext + lane; u32x2* o8 = (u32x2*)xn + lane;
#pragma unroll
        for (int j = 0; j < 4; ++j) { const f32x4 gg = gn[64 * j]; u32x2 w; w.x = pk2(v[j].x * rs2 * gg.x, v[j].y * rs2 * gg.y); w.y = pk2(v[j].z * rs2 * gg.z, v[j].w * rs2 * gg.w); o8[64 * j] = w; }
    }
}
__device__ __forceinline__ void p0_prologue(const Ctx& C) {
    int tid_ = threadIdx.x; asm volatile("" : "+v"(tid_)); const int tid = tid_, lane = tid & 63, wave = __builtin_amdgcn_readfirstlane(tid >> 6); (void)tid; (void)lane; (void)wave;
    bf16_t* Wb = (bf16_t*)(C.ws + WS_W);
    float* scr = (float*)(C.lds + wave * 16384);
    const int gw = blockIdx.x * 8 + wave, NGW = C.G * 8;
    constexpr int I_IN = 16 * 184, I_BR = 8 * 32, I_OUT = 16 * 32, I_UP = 16 * 176, I_DN = 44 * 32, I_L = I_IN + 3 * I_BR + I_OUT + I_UP + I_DN;
    for (int it = gw; it < 2 * I_L; it += NGW) {
        const int l = it / I_L; int r = it - l * I_L;
        if (r < I_IN) { transpose_item(C.in[5] + (size_t)l * 1024 * DIN, 1024, DIN, Wb + OW_IN + (size_t)l * DIN * 1024, scr, r, lane); continue; } r -= I_IN;
        if (r < 3 * I_BR) { const int n = r / I_BR; transpose_item(C.in[12] + (size_t)(l * 3 + n) * 512 * 1024, 512, 1024, Wb + OW_BR + (size_t)(l * 3 + n) * 1024 * 512, scr, r - n * I_BR, lane); continue; } r -= 3 * I_BR;
        if (r < I_OUT) { transpose_item(C.in[13] + (size_t)l * 1024 * 1024, 1024, 1024, Wb + OW_OUT + (size_t)l * 1024 * 1024, scr, r, lane); continue; } r -= I_OUT;
        if (r < I_UP) { transpose_item(C.in[14] + (size_t)l * 1024 * DUP, 1024, DUP, Wb + OW_UP + (size_t)l * DUP * 1024, scr, r, lane); continue; } r -= I_UP;
        transpose_item(C.in[17] + (size_t)l * DFF * 1024, DFF, 1024, Wb + OW_DN + (size_t)l * 1024 * DFF, scr, r, lane);
    }
    for (int idx = blockIdx.x * 512 + tid; idx < 2 * 512 * 512; idx += C.G * 512) {
        const int l = idx >> 18, n = (idx >> 9) & 511, k = idx & 511, g = n >> 7;
        float v = 0.f;
        if ((k >> 7) == g) v = C.in[9][((size_t)(l * 4 + g) * 128 + (k & 127)) * 128 + (n & 127)] * C.in[10][l * 512 + n];
        Wb[OW_POOL + idx] = (bf16_t)(pk2(v, 0.f) & 0xffffu);
    }
    bf16_t* XN = (bf16_t*)(C.ws + WS_XN);
    for (int m = gw; m < NTOK; m += NGW) norm_row(C.in[0] + (size_t)m * DM, C.in[1], XN + (size_t)m * DM, lane);
}

__device__ __forceinline__ void p2_prep(const Ctx& C, int l) {
    bf16_t* P = (bf16_t*)(C.ws + WS_BIG);
    bf16_t* DIFF = (bf16_t*)(C.ws + WS_XN);
    bf16_t* VCT = (bf16_t*)(C.ws + WS_XN + 32 * MiB);
    bf16_t* VAT = (bf16_t*)(C.ws + WS_VAT);
    bf16_t* T1 = (bf16_t*)C.lds;
    bf16_t* T2 = (bf16_t*)(C.lds + 17408);
    const float* gq = C.in[7] + l * 64; const float* gk = C.in[8] + l * 64;
    int tid_ = threadIdx.x; asm volatile("" : "+v"(tid_)); const int tid = tid_, lane = tid & 63, wave = __builtin_amdgcn_readfirstlane(tid >> 6); (void)tid; (void)lane; (void)wave;
    const int w = wave;
    const float gql = gq[lane], gkl = gk[lane];
    const float freq = __builtin_amdgcn_exp2f(-13.287712379549449f * (float)(lane & 15) * (1.f / 16.f));
    for (int u = blockIdx.x; u < NTOK / 64; u += C.G) {
        const int tok0 = u * 64, b = tok0 >> 11, s0 = tok0 & 2047;
        for (int i = tid; i < 64 * 16; i += 512) { const int r = i >> 4, c = i & 15; *(u32x4*)(T1 + r * 136 + 8 * c) = *(const u32x4*)(P + (size_t)(tok0 + r) * DIN + C_VA + 8 * c); }
        for (int i = tid; i < 64 * 64; i += 512) { const int r = i >> 6, c = i & 63; *(u32x4*)(T2 + r * 520 + 8 * c) = *(const u32x4*)(P + (size_t)(tok0 + r) * DIN + C_VC + 8 * c); }
        for (int tt = 0; tt < 8; ++tt) {
            const int tok = tok0 + w * 8 + tt, t = tok & 2047;
            const float pos = (float)((lane < 32) ? (t >> 6) : (t & 63));
            const float ang = pos * freq; const float cs = __cosf(ang), sn = __sinf(ang);
            bf16_t* row = P + (size_t)tok * DIN;
            float xv[10];
#pragma unroll
            for (int hh = 0; hh < 10; ++hh) xv[hh] = bf2f(row[hh * 64 + lane]);
#pragma unroll
            for (int hh = 0; hh < 10; ++hh) {
                const float x = xv[hh];
                const float rs = rsqrtf(wave_sum(x * x) * (1.f / 64.f) + EPS);
                const float y = x * rs * (hh < 8 ? gql : gkl);
                const float pr = __shfl_xor(y, 16);
                float o = y * cs + ((lane & 16) ? pr : -pr) * sn;
                if (hh < 8) o *= 0.125f * LOG2E;
                row[hh * 64 + lane] = (bf16_t)(pk2(o, 0.f) & 0xffffu);
            }
        }
        for (int j = 0; j < 8; ++j) {
            const int item = tid + 512 * j, tk = item >> 6, ch8 = item & 63, g = ch8 >> 4, hw = 1 << g;
            const int t = s0 + tk; int lo = t - hw; if (lo < 0) lo = 0; int hi = t + hw; if (hi > SEQ) hi = SEQ;
            const bf16_t* base = P + (size_t)(b * SEQ) * DIN + C_POOL + 8 * ch8;
            float sum[8];
#pragma unroll
            for (int e = 0; e < 8; ++e) sum[e] = 0.f;
            for (int r = lo; r < hi; ++r) { const u32x4 v = *(const u32x4*)(base + (size_t)r * DIN);
                sum[0] += bflo(v.x); sum[1] += bfhi(v.x); sum[2] += bflo(v.y); sum[3] += bfhi(v.y); sum[4] += bflo(v.z); sum[5] += bfhi(v.z); sum[6] += bflo(v.w); sum[7] += bfhi(v.w); }
            const float inv = 1.f / (float)(hi - lo);
            const u32x4 sv = *(const u32x4*)(base + (size_t)t * DIN);
            u32x4 o; o.x = pk2(sum[0] * inv - bflo(sv.x), sum[1] * inv - bfhi(sv.x)); o.y = pk2(sum[2] * inv - bflo(sv.y), sum[3] * inv - bfhi(sv.y));
            o.z = pk2(sum[4] * inv - bflo(sv.z), sum[5] * inv - bfhi(sv.z)); o.w = pk2(sum[6] * inv - bflo(sv.w), sum[7] * inv - bfhi(sv.w));
            *(u32x4*)(DIFF + (size_t)(tok0 + tk) * 512 + 8 * ch8) = o;
        }
        __syncthreads();
        { const int rw = tid >> 2, seg = tid & 3; unsigned pkd[8];
#pragma unroll
          for (int k = 0; k < 8; ++k) pkd[k] = (unsigned)T1[(seg * 16 + 2 * k) * 136 + rw] | ((unsigned)T1[(seg * 16 + 2 * k + 1) * 136 + rw] << 16);
          bf16_t* dst = VAT + ((size_t)(b * 128 + rw)) * SEQ + s0 + seg * 16;
          *(u32x4*)dst = (u32x4){pkd[0], pkd[1], pkd[2], pkd[3]}; *(u32x4*)(dst + 8) = (u32x4){pkd[4], pkd[5], pkd[6], pkd[7]}; }
        { bf16_t* dst = VCT + ((size_t)(b * 512 + tid)) * SEQ + s0;
#pragma unroll
          for (int q4 = 0; q4 < 8; ++q4) { unsigned pkd[4];
#pragma unroll
            for (int k = 0; k < 4; ++k) pkd[k] = (unsigned)T2[(q4 * 8 + 2 * k) * 520 + tid] | ((unsigned)T2[(q4 * 8 + 2 * k + 1) * 520 + tid] << 16);
            *(u32x4*)(dst + q4 * 8) = (u32x4){pkd[0], pkd[1], pkd[2], pkd[3]}; } }
        __syncthreads();
    }
}

__device__ __forceinline__ void p3_attn(const Ctx& C, int l) {
    bf16_t* P = (bf16_t*)(C.ws + WS_BIG);
    const bf16_t* VAT = (const bf16_t*)(C.ws + WS_VAT);
    int tid_ = threadIdx.x; asm volatile("" : "+v"(tid_)); const int tid = tid_, lane = tid & 63, wave = __builtin_amdgcn_readfirstlane(tid >> 6); (void)tid; (void)lane; (void)wave;
    const int w = wave, hi = lane >> 5, l32 = lane & 31;
    const float Mb = 8.f * LOG2E * wave_max(fabsf(C.in[7][l * 64 + lane])) * wave_max(fabsf(C.in[8][l * 64 + lane]));
    const int pm = (l32 & ~12) | ((l32 & 4) << 1) | ((l32 & 8) >> 1);
    bf16_t* Ks = (bf16_t*)C.lds;
    bf16_t* Vs = Ks + 2 * 64 * 72;
    const int sr = tid >> 3, sc = tid & 7;
    for (int u = blockIdx.x; u < 1024; u += C.G) {
        const int b = u >> 6, h = (u >> 3) & 7, qb = u & 7, kvh = h >> 2;
        bf16_t* Qrow = P + (size_t)(b * SEQ + qb * 256 + w * 32 + l32) * DIN + h * 64;
        bf16x8 qf[4];
#pragma unroll
        for (int ks = 0; ks < 4; ++ks) qf[ks] = *(const bf16x8*)(Qrow + 16 * ks + 8 * hi);
        const bf16_t* Kg = P + (size_t)(b * SEQ + sr) * DIN + C_KA + kvh * 64 + 8 * sc;
        const bf16_t* Vg = VAT + (size_t)((b * 2 + kvh) * 64 + sr) * SEQ + 8 * sc;
        f32x16 O0, O1;
#pragma unroll
        for (int i = 0; i < 16; ++i) { O0[i] = 0.f; O1[i] = 0.f; }
        float lsum = 0.f;
        u32x4 kreg = *(const u32x4*)Kg, vreg = *(const u32x4*)Vg;
        __syncthreads();
        *(u32x4*)(Ks + sr * 72 + 8 * sc) = kreg; *(u32x4*)(Vs + sr * 72 + 8 * sc) = vreg;
        __syncthreads();
        for (int t = 0; t < 32; ++t) {
            const int buf = t & 1;
            if (t + 1 < 32) { kreg = *(const u32x4*)(Kg + (size_t)(t + 1) * 64 * DIN); vreg = *(const u32x4*)(Vg + (t + 1) * 64); }
            const bf16_t* Kb = Ks + buf * 64 * 72; const bf16_t* Vb = Vs + buf * 64 * 72;
            f32x16 S0, S1;
#pragma unroll
            for (int i = 0; i < 16; ++i) { S0[i] = 0.f; S1[i] = 0.f; }
#pragma unroll
            for (int ks = 0; ks < 4; ++ks) {
                const bf16x8 k0 = *(const bf16x8*)(Kb + pm * 72 + 16 * ks + 8 * hi);
                const bf16x8 k1 = *(const bf16x8*)(Kb + (32 + pm) * 72 + 16 * ks + 8 * hi);
                S0 = __builtin_amdgcn_mfma_f32_32x32x16_bf16(k0, qf[ks], S0, 0, 0, 0);
                S1 = __builtin_amdgcn_mfma_f32_32x32x16_bf16(k1, qf[ks], S1, 0, 0, 0);
            }
            float ls = 0.f;
#pragma unroll
            for (int i = 0; i < 16; ++i) { S0[i] = __builtin_amdgcn_exp2f(S0[i] - Mb); S1[i] = __builtin_amdgcn_exp2f(S1[i] - Mb); ls += S0[i] + S1[i]; }
            lsum += ls;
            bf16x8 p[4];
            { u32x4 a; a.x = pk2(S0[0], S0[1]); a.y = pk2(S0[2], S0[3]); a.z = pk2(S0[4], S0[5]); a.w = pk2(S0[6], S0[7]); p[0] = __builtin_bit_cast(bf16x8, a); }
            { u32x4 a; a.x = pk2(S0[8], S0[9]); a.y = pk2(S0[10], S0[11]); a.z = pk2(S0[12], S0[13]); a.w = pk2(S0[14], S0[15]); p[1] = __builtin_bit_cast(bf16x8, a); }
            { u32x4 a; a.x = pk2(S1[0], S1[1]); a.y = pk2(S1[2], S1[3]); a.z = pk2(S1[4], S1[5]); a.w = pk2(S1[6], S1[7]); p[2] = __builtin_bit_cast(bf16x8, a); }
            { u32x4 a; a.x = pk2(S1[8], S1[9]); a.y = pk2(S1[10], S1[11]); a.z = pk2(S1[12], S1[13]); a.w = pk2(S1[14], S1[15]); p[3] = __builtin_bit_cast(bf16x8, a); }
#pragma unroll
            for (int jj = 0; jj < 4; ++jj) {
                const bf16x8 v0 = *(const bf16x8*)(Vb + l32 * 72 + 16 * jj + 8 * hi);
                const bf16x8 v1 = *(const bf16x8*)(Vb + (32 + l32) * 72 + 16 * jj + 8 * hi);
                O0 = __builtin_amdgcn_mfma_f32_32x32x16_bf16(v0, p[jj], O0, 0, 0, 0);
                O1 = __builtin_amdgcn_mfma_f32_32x32x16_bf16(v1, p[jj], O1, 0, 0, 0);
            }
            if (t + 1 < 32) { *(u32x4*)(Ks + (buf ^ 1) * 64 * 72 + sr * 72 + 8 * sc) = kreg; *(u32x4*)(Vs + (buf ^ 1) * 64 * 72 + sr * 72 + 8 * sc) = vreg; }
            __syncthreads();
        }
        const float inv = 1.f / (lsum + __shfl_xor(lsum, 32));
#pragma unroll
        for (int i4 = 0; i4 < 4; ++i4) {
            u32x2 a; a.x = pk2(O0[4 * i4] * inv, O0[4 * i4 + 1] * inv); a.y = pk2(O0[4 * i4 + 2] * inv, O0[4 * i4 + 3] * inv);
            *(u32x2*)(Qrow + 8 * i4 + 4 * hi) = a;
            u32x2 c; c.x = pk2(O1[4 * i4] * inv, O1[4 * i4 + 1] * inv); c.y = pk2(O1[4 * i4 + 2] * inv, O1[4 * i4 + 3] * inv);
            *(u32x2*)(Qrow + 32 + 8 * i4 + 4 * hi) = c;
        }
    }
}

__device__ __forceinline__ void p3_natten(const Ctx& C, int l) {
    bf16_t* P = (bf16_t*)(C.ws + WS_BIG);
    const bf16_t* VCT = (const bf16_t*)(C.ws + WS_XN + 32 * MiB);
    int tid_ = threadIdx.x; asm volatile("" : "+v"(tid_)); const int tid = tid_, lane = tid & 63, wave = __builtin_amdgcn_readfirstlane(tid >> 6); (void)tid; (void)lane; (void)wave;
    const int h = wave, q = lane & 15, Qr = lane >> 4;
    const float* rpb = C.in[11] + (size_t)(l * 8 + h) * 15 * 31;
    for (int u = blockIdx.x; u < 2048; u += C.G) {
        const int b = u >> 7, r = (u >> 2) & 31, cgp = u & 3, c0 = cgp * 16;
        int kc0 = c0 - 8; kc0 = kc0 < 0 ? 0 : (kc0 > 32 ? 32 : kc0);
        int rs = r - 4; rs = rs < 0 ? 0 : (rs > 24 ? 24 : rs);
        const int c = c0 + q; int cs = c - 8; cs = cs < 0 ? 0 : (cs > 48 ? 48 : cs);
        bf16_t* qrow = P + (size_t)(b * SEQ + r * 64 + c) * DIN + C_QC + h * 64;
        const bf16x8 q0 = *(const bf16x8*)(qrow + 8 * Qr), q1 = *(const bf16x8*)(qrow + 32 + 8 * Qr);
        const int kcolA = 8 * (q >> 2) + (q & 3);
        f32x4 S[8][2];
#pragma unroll
        for (int rr = 0; rr < 8; ++rr) {
#pragma unroll
            for (int a = 0; a < 2; ++a) {
                const bf16_t* kp = P + (size_t)(b * SEQ + (rs + rr) * 64 + kc0 + kcolA + 4 * a) * DIN + C_KC + h * 64 + 8 * Qr;
                const bf16x8 k0 = *(const bf16x8*)kp, k1 = *(const bf16x8*)(kp + 32);
                f32x4 s = {0.f, 0.f, 0.f, 0.f};
                s = __builtin_amdgcn_mfma_f32_16x16x32_bf16(k0, q0, s, 0, 0, 0);
                s = __builtin_amdgcn_mfma_f32_16x16x32_bf16(k1, q1, s, 0, 0, 0);
                S[rr][a] = s;
            }
        }
        float mx = -3.0e38f;
#pragma unroll
        for (int rr = 0; rr < 8; ++rr)
#pragma unroll
            for (int a = 0; a < 2; ++a)
#pragma unroll
                for (int i = 0; i < 4; ++i) {
                    const int kc = kc0 + 8 * Qr + 4 * a + i;
                    const bool ok = (kc >= cs) && (kc < cs + 16);
                    const int dc = ok ? (kc - c + 15) : 0;
                    const float bias = rpb[(rs + rr - r + 7) * 31 + dc];
                    const float s = ok ? (S[rr][a][i] * 0.125f + bias) : -3.0e38f;
                    S[rr][a][i] = s; mx = fmaxf(mx, s);
                }
        mx = fmaxf(mx, __shfl_xor(mx, 16)); mx = fmaxf(mx, __shfl_xor(mx, 32));
        float sum = 0.f;
#pragma unroll
        for (int rr = 0; rr < 8; ++rr)
#pragma unroll
            for (int a = 0; a < 2; ++a)
#pragma unroll
                for (int i = 0; i < 4; ++i) { const float pv = __expf(S[rr][a][i] - mx); S[rr][a][i] = pv; sum += pv; }
        sum += __shfl_xor(sum, 16); sum += __shfl_xor(sum, 32);
        const float inv = 1.f / sum;
        f32x4 O[4];
#pragma unroll
        for (int d = 0; d < 4; ++d) O[d] = (f32x4){0.f, 0.f, 0.f, 0.f};
        const bf16_t* vbase = VCT + (size_t)((b * 8 + h) * 64 + q) * SEQ + kc0 + 8 * Qr;
#pragma unroll
        for (int rr = 0; rr < 8; ++rr) {
            u32x4 pa; pa.x = pk2(S[rr][0][0], S[rr][0][1]); pa.y = pk2(S[rr][0][2], S[rr][0][3]); pa.z = pk2(S[rr][1][0], S[rr][1][1]); pa.w = pk2(S[rr][1][2], S[rr][1][3]);
            const bf16x8 pb = __builtin_bit_cast(bf16x8, pa);
#pragma unroll
            for (int d = 0; d < 4; ++d) {
                const bf16x8 vv = *(const bf16x8*)(vbase + (size_t)(16 * d) * SEQ + (rs + rr) * 64);
                O[d] = __builtin_amdgcn_mfma_f32_16x16x32_bf16(vv, pb, O[d], 0, 0, 0);
            }
        }
#pragma unroll
        for (int d = 0; d < 4; ++d) { u32x2 o; o.x = pk2(O[d][0] * inv, O[d][1] * inv); o.y = pk2(O[d][2] * inv, O[d][3] * inv); *(u32x2*)(qrow + 16 * d + 4 * Qr) = o; }
    }
}

__device__ __forceinline__ void unpack8(const u32x4 v, float* f) { f[0] = bflo(v.x); f[1] = bfhi(v.x); f[2] = bflo(v.y); f[3] = bfhi(v.y); f[4] = bflo(v.z); f[5] = bfhi(v.z); f[6] = bflo(v.w); f[7] = bfhi(v.w); }
__device__ __forceinline__ void p8_convact(const Ctx& C, int l) {
    bf16_t* UP = (bf16_t*)(C.ws + WS_BIG);
    const bf16_t* HALO = (const bf16_t*)(C.ws + WS_VAT);
    const float* cw = C.in[15] + (size_t)l * 3 * DUP; const float* cb = C.in[16] + (size_t)l * DUP;
    int tid_ = threadIdx.x; asm volatile("" : "+v"(tid_)); const int tid = tid_, lane = tid & 63, wave = __builtin_amdgcn_readfirstlane(tid >> 6); (void)tid; (void)lane; (void)wave;
    const u32x4 zero = {0u, 0u, 0u, 0u};
    for (int it = blockIdx.x * 512 + tid; it < 512 * 352; it += C.G * 512) {
        const int ch = it / 352, ct = it - ch * 352, f = 8 * ct, row0 = ch * 64;
        float w0v[8], w1v[8], w2v[8], bvv[8], w0g[8], w1g[8], w2g[8], bgg[8];
#pragma unroll
        for (int e = 0; e < 8; ++e) { w0v[e] = cw[f + e]; w1v[e] = cw[DUP + f + e]; w2v[e] = cw[2 * DUP + f + e]; bvv[e] = cb[f + e];
            w0g[e] = cw[DFF + f + e]; w1g[e] = cw[DUP + DFF + f + e]; w2g[e] = cw[2 * DUP + DFF + f + e]; bgg[e] = cb[DFF + f + e]; }
        bf16_t* vp = UP + (size_t)row0 * DUP + f; const bf16_t* gp = vp + DFF;
        const bool first = (row0 & 2047) == 0, last = ((row0 + 64) & 2047) == 0;
        u32x4 pv = first ? zero : *(const u32x4*)(HALO + (size_t)((ch - 1) * 2 + 1) * DFF + f);
        u32x4 pg = first ? zero : *(const u32x4*)(gp - DUP);
        u32x4 cv = *(const u32x4*)vp, cgt = *(const u32x4*)gp;
        for (int r4 = 0; r4 < 64; r4 += 4) {
            u32x4 nv[4], ng[4];
#pragma unroll
            for (int k = 0; k < 4; ++k) {
                const int r = r4 + k + 1;
                if (r < 64) { nv[k] = *(const u32x4*)(vp + (size_t)r * DUP); ng[k] = *(const u32x4*)(gp + (size_t)r * DUP); }
                else { nv[k] = last ? zero : *(const u32x4*)(HALO + (size_t)((ch + 1) * 2) * DFF + f); ng[k] = last ? zero : *(const u32x4*)(gp + (size_t)64 * DUP); }
            }
#pragma unroll
            for (int k = 0; k < 4; ++k) {
                float a[8], bq[8], c[8], ga[8], gb[8], gc[8];
                unpack8(pv, a); unpack8(cv, bq); unpack8(nv[k], c); unpack8(pg, ga); unpack8(cgt, gb); unpack8(ng[k], gc);
                float o[8];
#pragma unroll
                for (int e = 0; e < 8; ++e) {
                    const float val = a[e] * w0v[e] + bq[e] * w1v[e] + c[e] * w2v[e] + bvv[e];
                    const float x = ga[e] * w0g[e] + gb[e] * w1g[e] + gc[e] * w2g[e] + bgg[e];
                    const float t2 = 1.5957691216057308f * (x + 0.044715f * x * x * x);
                    const float ge = x * __builtin_amdgcn_rcpf(1.f + __expf(-t2));
                    o[e] = ge * val;
                }
                u32x4 ov; ov.x = pk2(o[0], o[1]); ov.y = pk2(o[2], o[3]); ov.z = pk2(o[4], o[5]); ov.w = pk2(o[6], o[7]);
                *(u32x4*)(vp + (size_t)(r4 + k) * DUP) = ov;
                pv = cv; pg = cgt; cv = nv[k]; cgt = ng[k];
            }
        }
    }
}

#ifndef GEMM_MASK
#define GEMM_MASK 63
#endif
#define GEMM_CALL1 if ((GEMM_MASK >> 0) & 1)
#define GEMM_CALL2 if ((GEMM_MASK >> 1) & 1)
#define GEMM_CALL3 if ((GEMM_MASK >> 2) & 1)
#define GEMM_CALL4 if ((GEMM_MASK >> 3) & 1)
#define GEMM_CALL5 if ((GEMM_MASK >> 4) & 1)
#define GEMM_CALL6 if ((GEMM_MASK >> 5) & 1)
struct Args { const float* in[18]; float* out; unsigned char* ws; int ph_lo, ph_hi; };
constexpr int N_PHASES = 21;

__global__ void __launch_bounds__(512, 2) fwd_mega(Args args) {
    extern __shared__ __attribute__((aligned(16))) unsigned char lds[];
    cg::grid_group grid = cg::this_grid();
    Ctx C;
#pragma unroll
    for (int i = 0; i < 18; ++i) C.in[i] = args.in[i];
    C.out = args.out; C.ws = args.ws; C.lds = lds; C.G = gridDim.x;
    PG8_LAS unsigned char* ldsg = (PG8_LAS unsigned char*)lds;
    bf16_t* Wb = (bf16_t*)(C.ws + WS_W);
    bf16_t* XN = (bf16_t*)(C.ws + WS_XN);
    bf16_t* BIG = (bf16_t*)(C.ws + WS_BIG);
    for (int ph = args.ph_lo; ph < args.ph_hi; ++ph) {
        if (ph == 0) {
#ifndef NO_P0
 p0_prologue(C);
#endif
 }
        else {
            const int l = (ph - 1) / 10, k = (ph - 1) % 10;
            if (k == 0) {
                __syncthreads();
                pg8::Gemm g{XN, Wb + OW_IN + (size_t)l * DIN * 1024, 1024, 1024, 1024};
                pg8::StdSched S{128, 23, C.G, (int)blockIdx.x, (size_t)256 * 1024 * 2, (size_t)256 * 1024 * 2};
                EpiProj E{BIG, C.in[6] + l * 3072};
                GEMM_CALL1 pg8::gemm_phase<EpiProj, pg8::StdSched, true, true>(ldsg, g, S, E);
            } else if (k == 1) {
                __syncthreads();
#ifndef NO_P2
                p2_prep(C, l);
#endif
            } else if (k == 2) {
                __syncthreads();
#ifndef NO_ATT
                p3_attn(C, l);
#endif
#ifndef NO_NAT
                p3_natten(C, l);
#endif
                __syncthreads();
                pg8::Gemm g{(const bf16_t*)(C.ws + WS_XN), Wb + OW_POOL + (size_t)l * 512 * 512, 512, 512, 512};
                pg8::StdSched S{128, 2, C.G, (int)blockIdx.x, (size_t)256 * 512 * 2, (size_t)256 * 512 * 2};
                EpiPlain E{BIG + C_POOL, DIN};
                GEMM_CALL2 pg8::gemm_phase<EpiPlain, pg8::StdSched, true, true>(ldsg, g, S, E);
            } else if (k == 3) {
                __syncthreads();
                pg8::Gemm g{BIG, Wb + OW_BR + (size_t)l * 3 * 1024 * 512, DIN, 512, 512};
                BranchSched S{C.G, (int)blockIdx.x};
                EpiBranch E{BIG, XN};
                GEMM_CALL3 pg8::gemm_phase<EpiBranch, BranchSched, true, true>(ldsg, g, S, E);
            } else if (k == 4) {
                __syncthreads();
                pg8::Gemm g{XN, Wb + OW_OUT + (size_t)l * 1024 * 1024, 1024, 1024, 1024};
                pg8::StdSched S{128, 4, C.G, (int)blockIdx.x, (size_t)256 * 1024 * 2, (size_t)256 * 1024 * 2};
                EpiPlain E{BIG, DM};
                GEMM_CALL4 pg8::gemm_phase<EpiPlain, pg8::StdSched, true, true>(ldsg, g, S, E);
            } else if (k == 5) {
                int tid_ = threadIdx.x; asm volatile("" : "+v"(tid_)); const int lane = tid_ & 63, gw = blockIdx.x * 8 + __builtin_amdgcn_readfirstlane(tid_ >> 6), NGW = C.G * 8;
                const float* xin = (l == 0) ? C.in[0] : C.out;
                for (int m = gw; m < NTOK; m += NGW)
                    resnorm_row(BIG + (size_t)m * DM, xin + (size_t)m * DM, C.in[2] + l * DM, C.out + (size_t)m * DM, C.in[3] + l * DM, XN + (size_t)m * DM, lane);
            } else if (k == 6) {
                __syncthreads();
                pg8::Gemm g{XN, Wb + OW_UP + (size_t)l * DUP * 1024, 1024, 1024, 1024};
                pg8::StdSched S{128, 22, C.G, (int)blockIdx.x, (size_t)256 * 1024 * 2, (size_t)256 * 1024 * 2};
                EpiUp E{BIG, (bf16_t*)(C.ws + WS_VAT)};
                GEMM_CALL5 pg8::gemm_phase<EpiUp, pg8::StdSched, true, true>(ldsg, g, S, E);
            } else if (k == 7) {
#ifndef NO_P8
                p8_convact(C, l);
#endif
            } else if (k == 8) {
                __syncthreads();
                pg8::Gemm g{BIG, Wb + OW_DN + (size_t)l * 1024 * DFF, DUP, DFF, DFF};
                pg8::StdSched S{128, 4, C.G, (int)blockIdx.x, (size_t)256 * DUP * 2, (size_t)256 * DFF * 2};
                EpiPlain E{XN, DM};
                GEMM_CALL6 pg8::gemm_phase<EpiPlain, pg8::StdSched, true, true>(ldsg, g, S, E);
            } else {
                int tid_ = threadIdx.x; asm volatile("" : "+v"(tid_)); const int lane = tid_ & 63, gw = blockIdx.x * 8 + __builtin_amdgcn_readfirstlane(tid_ >> 6), NGW = C.G * 8;
                const float* gnext = (l == 0) ? (C.in[1] + DM) : nullptr;
                for (int m = gw; m < NTOK; m += NGW)
                    resnorm_row(XN + (size_t)m * DM, C.out + (size_t)m * DM, C.in[4] + l * DM, C.out + (size_t)m * DM, gnext, XN + (size_t)m * DM, lane);
            }
        }
        if (ph + 1 < args.ph_hi) grid.sync();
    }
}

#ifndef MK_N_LAUNCHES
#define MK_N_LAUNCHES 1
#endif
extern "C" void kernel_launch(void* const* d_in, const int* in_sizes, int n_in, void* d_out, int out_size, void* d_ws, size_t ws_size, hipStream_t stream) {
    static int grid = 0;
    if (grid == 0) {
        if (n_in != 18 || out_size != NTOK * DM || ws_size < WS_END) { fprintf(stderr, "kernel_launch: unexpected shapes (n_in %d out %d ws %zu)\n", n_in, out_size, ws_size); grid = -1; return; }
        int dev = 0, cus = 0, per_cu = 0;
        hipGetDevice(&dev); hipDeviceGetAttribute(&cus, hipDeviceAttributeMultiprocessorCount, dev);
        if (hipFuncSetAttribute((const void*)fwd_mega, hipFuncAttributeMaxDynamicSharedMemorySize, LDS_BYTES) != hipSuccess) { fprintf(stderr, "kernel_launch: hipFuncSetAttribute failed\n"); grid = -1; return; }
        if (hipOccupancyMaxActiveBlocksPerMultiprocessor(&per_cu, (const void*)fwd_mega, 512, LDS_BYTES) != hipSuccess || per_cu < 1) { fprintf(stderr, "kernel_launch: occupancy query says %d\n", per_cu); per_cu = 1; }
        (void)hipGetLastError();
        grid = cus;
    }
    if (grid < 0) return;
    Args a{};
    for (int i = 0; i < 18; ++i) a.in[i] = (const float*)d_in[i];
    a.out = (float*)d_out; a.ws = (unsigned char*)d_ws;
    if (MK_N_LAUNCHES == 1) {
        a.ph_lo = 0; a.ph_hi = N_PHASES;
        void* kargs[] = {&a};
        hipError_t e = hipLaunchCooperativeKernel((const void*)fwd_mega, dim3(grid), dim3(512), kargs, LDS_BYTES, stream);
        if (e != hipSuccess) fprintf(stderr, "cooperative launch failed: %s (grid %d)\n", hipGetErrorString(e), grid);
    } else {
        for (int ph = 0; ph < N_PHASES; ++ph) { a.ph_lo = ph; a.ph_hi = ph + 1; hipLaunchKernelGGL(fwd_mega, dim3(grid), dim3(512), LDS_BYTES, stream, a); }
    }
}
```

```cpp
#include <hip/hip_runtime.h>
#include <hip/hip_cooperative_groups.h>
#include <cstdio>
#include <cstdint>
namespace cg = cooperative_groups;

namespace pg8 {
#define PG8_LAS __attribute__((address_space(3)))
typedef unsigned short bf16_t;
typedef short bf16x8 __attribute__((ext_vector_type(8)));
typedef float f32x4 __attribute__((ext_vector_type(4)));
typedef unsigned u32x4 __attribute__((ext_vector_type(4)));
constexpr int BM = 256, BK = 64, HALF = 128, HTB = HALF * BK * 2, STAGE_BYTES = 8 * HTB, NXCD = 8, WGM = 8;

__host__ __device__ __forceinline__ int lds_byte(int r, int c) { const int st = (r >> 4) * 2 + (c >> 5), rr = r & 15, cc = c & 31, ob = rr * 64 + cc * 2; return st * 1024 + (ob ^ (((ob >> 9) & 1) << 5)); }
__host__ __device__ __forceinline__ void stage_rc(int b, int& R, int& C) { const int st = b / 1024, sb = b % 1024, swz = sb ^ (((sb >> 9) & 1) << 5); R = (st >> 1) * 16 + swz / 64; C = (st & 1) * 32 + (swz % 64) / 2; }
__host__ __device__ __forceinline__ int perm32(int rho) { const int n = rho >> 4, i = rho & 15; return 8 * (i >> 2) + 4 * n + (i & 3); }

struct Unit { int pm, pn, n; size_t aoff, boff; };
struct Gemm { const bf16_t* A; const bf16_t* Bt; int lda, ldb, K; };

__device__ __forceinline__ void tile_of(int L, int nM, int nN, int& pm, int& pn) {
    const int nwg = nM * nN; int wgid = L; { const int q = nwg / NXCD, r = nwg % NXCD, xcd = wgid % NXCD, off = wgid / NXCD; wgid = (xcd < r ? xcd * (q + 1) : r * (q + 1) + (xcd - r) * q) + off; }
    const int nig = WGM * nN, gid = wgid / nig, fm = gid * WGM, gsz = (nM - fm) < WGM ? (nM - fm) : WGM;
    pm = fm + ((wgid % nig) % gsz); pn = (wgid % nig) / gsz;
}
struct StdSched {
    int nM, nN, G, c; size_t astep, bstep;
    __device__ __forceinline__ bool next(int i, Unit& u) const {
        const long L = (long)i * G + c; if (L >= (long)nM * nN) return false;
        tile_of((int)L, nM, nN, u.pm, u.pn); u.n = 0; u.aoff = (size_t)u.pm * astep; u.boff = (size_t)u.pn * bstep; return true;
    }
    __device__ __forceinline__ void a_ready(const Unit&) const {}
    __device__ __forceinline__ void done(const Unit&) const {}
};
__device__ __forceinline__ unsigned cvt_pk_bf16(float lo, float hi) { unsigned r; asm volatile("v_cvt_pk_bf16_f32 %0, %1, %2" : "=v"(r) : "v"(lo), "v"(hi)); return r; }
template <class Epi, class Sched, bool ALIGN_EPI = false, bool SP2 = false>
__device__ __forceinline__ void gemm_phase(PG8_LAS unsigned char* lds, const Gemm g, const Sched& S, const Epi& E) {
    int tid_ = threadIdx.x; asm volatile("" : "+v"(tid_));
    const int tid = tid_, wid = __builtin_amdgcn_readfirstlane(tid >> 6), lane = tid & 63, wr = wid >> 2, wc = wid & 3, fr = lane & 15, fq = lane >> 4;
    const int K = g.K, nt = K / BK;
    unsigned voffA[2], voffB[2];
#pragma unroll
    for (int i = 0; i < 2; ++i) { int R, C; stage_rc(tid * 16 + i * 8192, R, C); const int Rb = Epi::PERM ? ((R & ~31) + perm32(R & 31)) : R;
        voffA[i] = (unsigned)(R * g.lda + C) * 2u; voffB[i] = (unsigned)(Rb * g.ldb + C) * 2u; }
    const size_t kstep = (size_t)(BK * 2);
    const size_t hstepA = (size_t)HALF * g.lda * 2, hstepB = (size_t)HALF * g.ldb * 2;
    const unsigned ldsw = (unsigned)wid * 1024u;
    const int aoff = lds_byte(wr * 64 + fr, fq * 8), boff = lds_byte(wc * 32 + fr, fq * 8);
#define PG8_SA(b, h) (((b) * 2 + (h)) * HTB)
#define PG8_SB(b, h) ((4 + (b) * 2 + (h)) * HTB)
#define PG8_STAGE(bufoff, gbase, voff) do { _Pragma("unroll") for (int _i = 0; _i < 2; ++_i) \
        __builtin_amdgcn_global_load_lds((const unsigned*)((const char*)(gbase) + (voff)[_i]), (PG8_LAS unsigned*)(lds + (bufoff) + ldsw + _i * 8192), 16, 0, 0); } while (0)
#define PG8_LDA(dst, b, h) do { _Pragma("unroll") for (int m = 0; m < 4; ++m) _Pragma("unroll") for (int k = 0; k < 2; ++k) dst[m][k] = *(const PG8_LAS bf16x8*)(lds + PG8_SA(b, h) + aoff + m * 2048 + k * 1024); } while (0)
#define PG8_LDB(dst, b, h) do { _Pragma("unroll") for (int n = 0; n < 2; ++n) _Pragma("unroll") for (int k = 0; k < 2; ++k) dst[n][k] = *(const PG8_LAS bf16x8*)(lds + PG8_SB(b, h) + boff + n * 2048 + k * 1024); } while (0)
#define PG8_MMA(ai, bj, At, Bt) do { __builtin_amdgcn_s_setprio(1); _Pragma("unroll") for (int m = 0; m < 4; ++m) _Pragma("unroll") for (int n = 0; n < 2; ++n) _Pragma("unroll") for (int k = 0; k < 2; ++k) \
        acc[ai][bj][m][n] = __builtin_amdgcn_mfma_f32_16x16x32_bf16(Bt[n][k], At[m][k], acc[ai][bj][m][n], 0, 0, 0); __builtin_amdgcn_s_setprio(0); } while (0)
#define PG8_WAIT_V(n) asm volatile("s_waitcnt vmcnt(" #n ")" ::: "memory")
#define PG8_WAIT_L(n) asm volatile("s_waitcnt lgkmcnt(" #n ")" ::: "memory")
#define PG8_BAR __builtin_amdgcn_s_barrier()
#define PG8_SCHED __builtin_amdgcn_sched_barrier(0)
    Unit cur, nxt; int ui = 0;
    if (!S.next(0, cur)) return;
    f32x4 acc[2][2][4][2];
#pragma unroll
    for (int a = 0; a < 2; ++a)
#pragma unroll
        for (int b = 0; b < 2; ++b)
#pragma unroll
            for (int m = 0; m < 4; ++m)
#pragma unroll
                for (int n = 0; n < 2; ++n) acc[a][b][m][n] = (f32x4){0.f, 0.f, 0.f, 0.f};
    bf16x8 At[4][2], B0[2][2], B1[2][2];
    const char* cA = (const char*)g.A + cur.aoff; const char* cB = (const char*)g.Bt + cur.boff;
    S.a_ready(cur);
    if constexpr (SP2) {
        PG8_STAGE(PG8_SB(0, 0), cB, voffB); PG8_STAGE(PG8_SB(0, 1), cB + hstepB, voffB); PG8_STAGE(PG8_SA(0, 0), cA, voffA); PG8_STAGE(PG8_SA(0, 1), cA + hstepA, voffA);
        if (wr == 1) PG8_BAR;
        PG8_WAIT_V(2); PG8_BAR;
        PG8_STAGE(PG8_SB(1, 0), cB + kstep, voffB); PG8_STAGE(PG8_SA(1, 0), cA + kstep, voffA); PG8_STAGE(PG8_SB(1, 1), cB + hstepB + kstep, voffB);
        PG8_WAIT_V(6); PG8_BAR;
    } else {
        PG8_STAGE(PG8_SB(0, 0), cB, voffB); PG8_STAGE(PG8_SA(0, 0), cA, voffA); PG8_STAGE(PG8_SB(0, 1), cB + hstepB, voffB); PG8_STAGE(PG8_SA(0, 1), cA + hstepA, voffA);
        if (wr == 1) PG8_BAR;
        PG8_WAIT_V(4); PG8_BAR;
        PG8_STAGE(PG8_SB(1, 0), cB + kstep, voffB); PG8_STAGE(PG8_SA(1, 0), cA + kstep, voffA); PG8_STAGE(PG8_SB(1, 1), cB + hstepB + kstep, voffB);
        PG8_WAIT_V(6); PG8_BAR;
    }
    for (;;) {
        const bool has_next = S.next(ui + 1, nxt);
        const char* nA = has_next ? (const char*)g.A + nxt.aoff : cA; const char* nB = has_next ? (const char*)g.Bt + nxt.boff : cB;
        for (int t = 0; t < nt; t += 2) {
            const bool last = (t == nt - 2);
            const char* a1 = cA + (size_t)(t + 1) * kstep;
            const char* a2 = last ? nA : cA + (size_t)(t + 2) * kstep; const char* b2 = last ? nB : cB + (size_t)(t + 2) * kstep;
            const char* a3 = a2 + kstep; const char* b3 = b2 + kstep;
            if (last && has_next) S.a_ready(nxt);
            if constexpr (SP2) {
            PG8_LDB(B0, 0, 0); PG8_LDB(B1, 0, 1); PG8_SCHED; PG8_LDA(At, 0, 0); PG8_STAGE(PG8_SA(1, 1), a1 + hstepA, voffA);
            PG8_WAIT_V(8); PG8_WAIT_L(0); PG8_BAR; PG8_MMA(0, 0, At, B0); PG8_MMA(0, 1, At, B1); PG8_BAR; PG8_SCHED;
            PG8_LDA(At, 0, 1); PG8_STAGE(PG8_SB(0, 0), b2, voffB); PG8_STAGE(PG8_SB(0, 1), b2 + hstepB, voffB); PG8_STAGE(PG8_SA(0, 0), a2, voffA);
            PG8_WAIT_V(8); PG8_WAIT_L(0); PG8_BAR; PG8_MMA(1, 0, At, B0); PG8_MMA(1, 1, At, B1); PG8_BAR; PG8_SCHED;
            PG8_LDB(B0, 1, 0); PG8_LDB(B1, 1, 1); PG8_SCHED; PG8_LDA(At, 1, 0); PG8_STAGE(PG8_SA(0, 1), a2 + hstepA, voffA);
            PG8_WAIT_V(8); PG8_WAIT_L(0); PG8_BAR; PG8_MMA(0, 0, At, B0); PG8_MMA(0, 1, At, B1); PG8_BAR; PG8_SCHED;
            PG8_LDA(At, 1, 1); PG8_STAGE(PG8_SB(1, 0), b3, voffB); PG8_STAGE(PG8_SB(1, 1), b3 + hstepB, voffB); PG8_STAGE(PG8_SA(1, 0), a3, voffA);
            PG8_WAIT_V(8); PG8_WAIT_L(0); PG8_BAR; PG8_MMA(1, 0, At, B0); PG8_MMA(1, 1, At, B1); PG8_BAR; PG8_SCHED;
            } else {
            PG8_LDB(B0, 0, 0); PG8_SCHED; PG8_LDA(At, 0, 0); PG8_STAGE(PG8_SA(1, 1), a1 + hstepA, voffA);
            PG8_WAIT_L(8); PG8_BAR; PG8_WAIT_L(0); PG8_MMA(0, 0, At, B0); PG8_BAR; PG8_SCHED;
            PG8_LDB(B1, 0, 1); PG8_STAGE(PG8_SB(0, 0), b2, voffB);
            PG8_BAR; PG8_WAIT_L(0); PG8_MMA(0, 1, At, B1); PG8_BAR;
            PG8_LDA(At, 0, 1); PG8_STAGE(PG8_SA(0, 0), a2, voffA);
            PG8_BAR; PG8_WAIT_L(0); PG8_MMA(1, 0, At, B0); PG8_BAR; PG8_SCHED;
            PG8_STAGE(PG8_SB(0, 1), b2 + hstepB, voffB);
            PG8_WAIT_V(6); PG8_BAR; PG8_MMA(1, 1, At, B1); PG8_BAR;
            PG8_LDB(B0, 1, 0); PG8_SCHED; PG8_LDA(At, 1, 0); PG8_STAGE(PG8_SA(0, 1), a2 + hstepA, voffA);
            PG8_WAIT_L(8); PG8_BAR; PG8_WAIT_L(0); PG8_MMA(0, 0, At, B0); PG8_BAR; PG8_SCHED;
            PG8_LDB(B1, 1, 1); PG8_STAGE(PG8_SB(1, 0), b3, voffB);
            PG8_BAR; PG8_WAIT_L(0); PG8_MMA(0, 1, At, B1); PG8_BAR;
            PG8_LDA(At, 1, 1); PG8_STAGE(PG8_SA(1, 0), a3, voffA);
            PG8_BAR; PG8_WAIT_L(0); PG8_MMA(1, 0, At, B0); PG8_BAR; PG8_SCHED;
            PG8_STAGE(PG8_SB(1, 1), b3 + hstepB, voffB);
            PG8_WAIT_V(6); PG8_BAR; PG8_MMA(1, 1, At, B1); PG8_BAR;
            }
        }
        if constexpr (ALIGN_EPI) { if (wr == 0) PG8_BAR; }
        if constexpr (!Epi::AFTER_DRAIN) { E(acc, cur, wr, wc, fr, fq); S.done(cur); }
        if (!has_next) break;
#pragma unroll
        for (int a = 0; a < 2; ++a)
#pragma unroll
            for (int b = 0; b < 2; ++b)
#pragma unroll
                for (int m = 0; m < 4; ++m)
#pragma unroll
                    for (int n = 0; n < 2; ++n) acc[a][b][m][n] = (f32x4){0.f, 0.f, 0.f, 0.f};
        cur = nxt; cA = nA; cB = nB; ++ui;
        if constexpr (ALIGN_EPI) { if (wr == 1) PG8_BAR; }
    }
    PG8_WAIT_V(0);
    if constexpr (!ALIGN_EPI) { if (wr == 0) PG8_BAR; }
    PG8_BAR;
    if constexpr (Epi::AFTER_DRAIN) { E.fused(acc, cur, wr, wc, fr, fq, lds, wid, lane); S.done(cur); }
#undef PG8_SA
#undef PG8_SB
#undef PG8_STAGE
#undef PG8_LDA
#undef PG8_LDB
#undef PG8_MMA
#undef PG8_WAIT_V
#undef PG8_WAIT_L
#undef PG8_BAR
#undef PG8_SCHED
}
}

typedef unsigned short bf16_t;
typedef short bf16x8 __attribute__((ext_vector_type(8)));
typedef float f32x4 __attribute__((ext_vector_type(4)));
typedef float f32x16 __attribute__((ext_vector_type(16)));
typedef unsigned u32x4 __attribute__((ext_vector_type(4)));
typedef unsigned u32x2 __attribute__((ext_vector_type(2)));
#define LAS __attribute__((address_space(3)))

constexpr int NTOK = 32768, DM = 1024, SEQ = 2048, DIN = 5888, DFF = 2816, DUP = 5632;
constexpr int C_KA = 512, C_VA = 640, C_POOL = 768, C_QC = 1280, C_KC = 1792, C_VC = 2304, C_GATE = 2816;
constexpr float EPS = 1e-6f, LOG2E = 1.4426950408889634f;
constexpr size_t MiB = (size_t)1 << 20;
constexpr size_t WS_W = 1 * MiB;
constexpr size_t WS_XN = 68 * MiB;
constexpr size_t WS_BIG = 132 * MiB;
constexpr size_t WS_VAT = 500 * MiB;
constexpr size_t WS_END = 508 * MiB;
constexpr size_t OW_IN = 0, OW_BR = 12058624, OW_OUT = 15204352, OW_UP = 17301504, OW_DN = 28835840, OW_POOL = 34603008;
constexpr int LDS_BYTES = 131072 + 1024;

__device__ __forceinline__ float bf2f(unsigned v) { return __uint_as_float(v << 16); }
__device__ __forceinline__ float bflo(unsigned u) { return __uint_as_float(u << 16); }
__device__ __forceinline__ float bfhi(unsigned u) { return __uint_as_float(u & 0xffff0000u); }
__device__ __forceinline__ unsigned pk2(float lo, float hi) { return pg8::cvt_pk_bf16(lo, hi); }
__device__ __forceinline__ float wave_sum(float v) {
#pragma unroll
    for (int o = 1; o < 64; o <<= 1) v += __shfl_xor(v, o);
    return v;
}
__device__ __forceinline__ float wave_max(float v) {
#pragma unroll
    for (int o = 1; o < 64; o <<= 1) v = fmaxf(v, __shfl_xor(v, o));
    return v;
}

struct EpiPlain {
    static constexpr bool PERM = true, AFTER_DRAIN = false;
    bf16_t* O; int ldc;
    __device__ __forceinline__ void operator()(const f32x4 (&acc)[2][2][4][2], const pg8::Unit& u, int wr, int wc, int fr, int fq) const {
        const int row0 = u.pm * 256 + wr * 64 + fr, col0 = u.pn * 256 + wc * 32 + 8 * fq;
#pragma unroll
        for (int ai = 0; ai < 2; ++ai)
#pragma unroll
            for (int m = 0; m < 4; ++m) { bf16_t* rowp = O + (size_t)(row0 + ai * 128 + m * 16) * ldc + col0;
#pragma unroll
                for (int bj = 0; bj < 2; ++bj) { const f32x4 v0 = acc[ai][bj][m][0], v1 = acc[ai][bj][m][1];
                    u32x4 w; w.x = pk2(v0[0], v0[1]); w.y = pk2(v0[2], v0[3]); w.z = pk2(v1[0], v1[1]); w.w = pk2(v1[2], v1[3]);
                    *(u32x4*)(rowp + bj * 128) = w; } }
    }
};
struct EpiProj {
    static constexpr bool PERM = true, AFTER_DRAIN = false;
    bf16_t* O; const float* bgate;
    __device__ __forceinline__ void operator()(const f32x4 (&acc)[2][2][4][2], const pg8::Unit& u, int wr, int wc, int fr, int fq) const {
        const int row0 = u.pm * 256 + wr * 64 + fr, col0 = u.pn * 256 + wc * 32 + 8 * fq;
        const bool gate = (u.pn >= 11);
        f32x4 bv[2][2];
#pragma unroll
        for (int bj = 0; bj < 2; ++bj)
#pragma unroll
            for (int n = 0; n < 2; ++n) bv[bj][n] = gate ? *(const f32x4*)(bgate + (col0 - C_GATE) + bj * 128 + 4 * n) : (f32x4){0.f, 0.f, 0.f, 0.f};
#pragma unroll
        for (int ai = 0; ai < 2; ++ai)
#pragma unroll
            for (int m = 0; m < 4; ++m) { bf16_t* rowp = O + (size_t)(row0 + ai * 128 + m * 16) * DIN + col0;
#pragma unroll
                for (int bj = 0; bj < 2; ++bj) { f32x4 v0 = acc[ai][bj][m][0], v1 = acc[ai][bj][m][1];
                    if (gate) {
#pragma unroll
                        for (int j = 0; j < 4; ++j) { v0[j] = __builtin_amdgcn_rcpf(1.f + __expf(-(v0[j] + bv[bj][0][j]))); v1[j] = __builtin_amdgcn_rcpf(1.f + __expf(-(v1[j] + bv[bj][1][j]))); }
                    }
                    u32x4 w; w.x = pk2(v0[0], v0[1]); w.y = pk2(v0[2], v0[3]); w.z = pk2(v1[0], v1[1]); w.w = pk2(v1[2], v1[3]);
                    *(u32x4*)(rowp + bj * 128) = w; } }
    }
};
struct EpiBranch {
    static constexpr bool PERM = true, AFTER_DRAIN = false;
    const bf16_t* P; bf16_t* MG;
    __device__ __forceinline__ void operator()(const f32x4 (&acc)[2][2][4][2], const pg8::Unit& u, int wr, int wc, int fr, int fq) const {
        const int row0 = u.pm * 256 + wr * 64 + fr, col0 = u.pn * 256 + wc * 32 + 8 * fq;
#pragma unroll
        for (int ai = 0; ai < 2; ++ai)
#pragma unroll
            for (int m = 0; m < 4; ++m) { const size_t r = (size_t)(row0 + ai * 128 + m * 16);
#pragma unroll
                for (int bj = 0; bj < 2; ++bj) { const int c = col0 + bj * 128;
                    const u32x4 gt = *(const u32x4*)(P + r * DIN + C_GATE + u.n * 1024 + c);
                    const f32x4 a0 = acc[ai][bj][m][0], a1 = acc[ai][bj][m][1];
                    float v[8];
                    v[0] = a0[0] * bflo(gt.x); v[1] = a0[1] * bfhi(gt.x); v[2] = a0[2] * bflo(gt.y); v[3] = a0[3] * bfhi(gt.y);
                    v[4] = a1[0] * bflo(gt.z); v[5] = a1[1] * bfhi(gt.z); v[6] = a1[2] * bflo(gt.w); v[7] = a1[3] * bfhi(gt.w);
                    bf16_t* mp = MG + r * DM + c;
                    if (u.n > 0) { const u32x4 od = *(const u32x4*)mp;
                        v[0] += bflo(od.x); v[1] += bfhi(od.x); v[2] += bflo(od.y); v[3] += bfhi(od.y); v[4] += bflo(od.z); v[5] += bfhi(od.z); v[6] += bflo(od.w); v[7] += bfhi(od.w); }
                    u32x4 w; w.x = pk2(v[0], v[1]); w.y = pk2(v[2], v[3]); w.z = pk2(v[4], v[5]); w.w = pk2(v[6], v[7]);
                    *(u32x4*)mp = w; } }
    }
};
struct BranchSched {
    int G, c;
    __device__ __forceinline__ bool next(int i, pg8::Unit& u) const {
        const int t = i / 3, n = i - 3 * t; const long L = (long)t * G + c; if (L >= 512) return false;
        pg8::tile_of((int)L, 128, 4, u.pm, u.pn); u.n = n;
        const int colA = (n == 0) ? 0 : (n == 1 ? C_POOL : C_QC);
        u.aoff = ((size_t)u.pm * 256 * DIN + colA) * 2; u.boff = ((size_t)(n * 1024 + u.pn * 256) * 512) * 2; return true;
    }
    __device__ __forceinline__ void a_ready(const pg8::Unit&) const {}
    __device__ __forceinline__ void done(const pg8::Unit&) const {}
};
struct EpiUp {
    static constexpr bool PERM = true, AFTER_DRAIN = false;
    bf16_t* O; bf16_t* HALO;
    __device__ __forceinline__ void operator()(const f32x4 (&acc)[2][2][4][2], const pg8::Unit& u, int wr, int wc, int fr, int fq) const {
        const int row0 = u.pm * 256 + wr * 64 + fr, col0 = u.pn * 256 + wc * 32 + 8 * fq;
        const bool val = (u.pn < 11);
#pragma unroll
        for (int ai = 0; ai < 2; ++ai)
#pragma unroll
            for (int m = 0; m < 4; ++m) { bf16_t* rowp = O + (size_t)(row0 + ai * 128 + m * 16) * DUP + col0;
#pragma unroll
                for (int bj = 0; bj < 2; ++bj) { const f32x4 v0 = acc[ai][bj][m][0], v1 = acc[ai][bj][m][1];
                    u32x4 w; w.x = pk2(v0[0], v0[1]); w.y = pk2(v0[2], v0[3]); w.z = pk2(v1[0], v1[1]); w.w = pk2(v1[2], v1[3]);
                    *(u32x4*)(rowp + bj * 128) = w;
                    if (val && m == 0 && fr == 0)  *(u32x4*)(HALO + ((size_t)((u.pm * 4 + ai * 2 + wr) * 2 + 0)) * DFF + col0 + bj * 128) = w;
                    if (val && m == 3 && fr == 15) *(u32x4*)(HALO + ((size_t)((u.pm * 4 + ai * 2 + wr) * 2 + 1)) * DFF + col0 + bj * 128) = w; } }
    }
};

struct Ctx {
    const float* in[18]; float* out; unsigned char* ws; unsigned char* lds; int G;
};

__device__ __forceinline__ void transpose_item(const float* W, int K, int N, bf16_t* WT, float* scr, int item, int lane) {
    const int nblk = N / 32, kb = item / nblk, nb = item % nblk, k0 = 64 * kb, n0 = 32 * nb;
#pragma unroll 8
    for (int i = 0; i < 32; ++i) { const int kk = 2 * i + (lane >> 5); scr[kk * 33 + (lane & 31)] = W[(size_t)(k0 + kk) * N + n0 + (lane & 31)]; }
    asm volatile("s_waitcnt lgkmcnt(0)" ::: "memory");
    const int c = lane & 7;
#pragma unroll
    for (int j = 0; j < 4; ++j) { const int n = (lane >> 3) + 8 * j; const float* s = scr + (8 * c) * 33 + n;
        u32x4 o; o.x = pk2(s[0 * 33], s[1 * 33]); o.y = pk2(s[2 * 33], s[3 * 33]); o.z = pk2(s[4 * 33], s[5 * 33]); o.w = pk2(s[6 * 33], s[7 * 33]);
        *(u32x4*)(WT + (size_t)(n0 + n) * K + k0 + 8 * c) = o; }
    asm volatile("s_waitcnt lgkmcnt(0)" ::: "memory");
}
__device__ __forceinline__ void norm_row(const float* xrow, const float* g, bf16_t* orow, int lane) {
    const f32x4* xr = (const f32x4*)xrow + lane; const f32x4* gr = (const f32x4*)g + lane;
    f32x4 v[4]; float s = 0.f;
#pragma unroll
    for (int j = 0; j < 4; ++j) { v[j] = xr[64 * j]; s += (v[j].x * v[j].x + v[j].y * v[j].y) + (v[j].z * v[j].z + v[j].w * v[j].w); }
    const float rs = rsqrtf(wave_sum(s) * (1.f / DM) + EPS);
    u32x2* o8 = (u32x2*)orow + lane;
#pragma unroll
    for (int j = 0; j < 4; ++j) { const f32x4 gg = gr[64 * j]; u32x2 w; w.x = pk2(v[j].x * rs * gg.x, v[j].y * rs * gg.y); w.y = pk2(v[j].z * rs * gg.z, v[j].w * rs * gg.w); o8[64 * j] = w; }
}
__device__ __forceinline__ void resnorm_row(const bf16_t* src, const float* xin, const float* gpost, float* xo, const float* gnext, bf16_t* xn, int lane) {
    const u32x2* sr = (const u32x2*)src + lane; const f32x4* xr = (const f32x4*)xin + lane; const f32x4* gp = (const f32x4*)gpost + lane;
    f32x4 v[4]; float s = 0.f;
#pragma unroll
    for (int j = 0; j < 4; ++j) { const u32x2 w = sr[64 * j]; v[j] = (f32x4){bflo(w.x), bfhi(w.x), bflo(w.y), bfhi(w.y)}; s += (v[j].x * v[j].x + v[j].y * v[j].y) + (v[j].z * v[j].z + v[j].w * v[j].w); }
    const float rs = rsqrtf(wave_sum(s) * (1.f / DM) + EPS);
    float s2 = 0.f;
#pragma unroll
    for (int j = 0; j < 4; ++j) { const f32x4 gg = gp[64 * j], xx = xr[64 * j]; v[j] = xx + v[j] * rs * gg; s2 += (v[j].x * v[j].x + v[j].y * v[j].y) + (v[j].z * v[j].z + v[j].w * v[j].w); }
    f32x4* xw = (f32x4*)xo + lane;
#pragma unroll
    for (int j = 0; j < 4; ++j) xw[64 * j] = v[j];
    if (gnext) {
        const float rs2 = rsqrtf(wave_sum(s2) * (1.f / DM) + EPS);
        const f32x4* gn = (const f32x4*)gnext + lane; u32x2* o8 = (u32x2*)xn + lane;
#pragma unroll
        for (int j = 0; j < 4; ++j) { const f32x4 gg = gn[64 * j]; u32x2 w; w.x = pk2(v[j].x * rs2 * gg.x, v[j].y * rs2 * gg.y); w.y = pk2(v[j].z * rs2 * gg.z, v[j].w * rs2 * gg.w); o8[64 * j] = w; }
    }
}
__device__ __forceinline__ void p0_prologue(const Ctx& C) {
    int tid_ = threadIdx.x; asm volatile("" : "+v"(tid_)); const int tid = tid_, lane = tid & 63, wave = __builtin_amdgcn_readfirstlane(tid >> 6); (void)tid; (void)lane; (void)wave;
    bf16_t* Wb = (bf16_t*)(C.ws + WS_W);
    float* scr = (float*)(C.lds + wave * 16384);
    const int gw = blockIdx.x * 8 + wave, NGW = C.G * 8;
    constexpr int I_IN = 16 * 184, I_BR = 8 * 32, I_OUT = 16 * 32, I_UP = 16 * 176, I_DN = 44 * 32, I_L = I_IN + 3 * I_BR + I_OUT + I_UP + I_DN;
    for (int it = gw; it < 2 * I_L; it += NGW) {
        const int l = it / I_L; int r = it - l * I_L;
        if (r < I_IN) { transpose_item(C.in[5] + (size_t)l * 1024 * DIN, 1024, DIN, Wb + OW_IN + (size_t)l * DIN * 1024, scr, r, lane); continue; } r -= I_IN;
        if (r < 3 * I_BR) { const int n = r / I_BR; transpose_item(C.in[12] + (size_t)(l * 3 + n) * 512 * 1024, 512, 1024, Wb + OW_BR + (size_t)(l * 3 + n) * 1024 * 512, scr, r - n * I_BR, lane); continue; } r -= 3 * I_BR;
        if (r < I_OUT) { transpose_item(C.in[13] + (size_t)l * 1024 * 1024, 1024, 1024, Wb + OW_OUT + (size_t)l * 1024 * 1024, scr, r, lane); continue; } r -= I_OUT;
        if (r < I_UP) { transpose_item(C.in[14] + (size_t)l * 1024 * DUP, 1024, DUP, Wb + OW_UP + (size_t)l * DUP * 1024, scr, r, lane); continue; } r -= I_UP;
        transpose_item(C.in[17] + (size_t)l * DFF * 1024, DFF, 1024, Wb + OW_DN + (size_t)l * 1024 * DFF, scr, r, lane);
    }
    for (int idx = blockIdx.x * 512 + tid; idx < 2 * 512 * 512; idx += C.G * 512) {
        const int l = idx >> 18, n = (idx >> 9) & 511, k = idx & 511, g = n >> 7;
        float v = 0.f;
        if ((k >> 7) == g) v = C.in[9][((size_t)(l * 4 + g) * 128 + (k & 127)) * 128 + (n & 127)] * C.in[10][l * 512 + n];
        Wb[OW_POOL + idx] = (bf16_t)(pk2(v, 0.f) & 0xffffu);
    }
    bf16_t* XN = (bf16_t*)(C.ws + WS_XN);
    for (int m = gw; m < NTOK; m += NGW) norm_row(C.in[0] + (size_t)m * DM, C.in[1], XN + (size_t)m * DM, lane);
}

__device__ __forceinline__ void p2_prep(const Ctx& C, int l) {
    bf16_t* P = (bf16_t*)(C.ws + WS_BIG);
    bf16_t* DIFF = (bf16_t*)(C.ws + WS_XN);
    bf16_t* VCT = (bf16_t*)(C.ws + WS_XN + 32 * MiB);
    bf16_t* VAT = (bf16_t*)(C.ws + WS_VAT);
    bf16_t* T1 = (bf16_t*)C.lds;
    bf16_t* T2 = (bf16_t*)(C.lds + 17408);
    const float* gq = C.in[7] + l * 64; const float* gk = C.in[8] + l * 64;
    int tid_ = threadIdx.x; asm volatile("" : "+v"(tid_)); const int tid = tid_, lane = tid & 63, wave = __builtin_amdgcn_readfirstlane(tid >> 6); (void)tid; (void)lane; (void)wave;
    const int w = wave;
    const float gql = gq[lane], gkl = gk[lane];
    const float freq = __builtin_amdgcn_exp2f(-13.287712379549449f * (float)(lane & 15) * (1.f / 16.f));
    for (int u = blockIdx.x; u < NTOK / 64; u += C.G) {
        const int tok0 = u * 64, b = tok0 >> 11, s0 = tok0 & 2047;
        for (int i = tid; i < 64 * 16; i += 512) { const int r = i >> 4, c = i & 15; *(u32x4*)(T1 + r * 136 + 8 * c) = *(const u32x4*)(P + (size_t)(tok0 + r) * DIN + C_VA + 8 * c); }
        for (int i = tid; i < 64 * 64; i += 512) { const int r = i >> 6, c = i & 63; *(u32x4*)(T2 + r * 520 + 8 * c) = *(const u32x4*)(P + (size_t)(tok0 + r) * DIN + C_VC + 8 * c); }
        for (int tt = 0; tt < 8; ++tt) {
            const int tok = tok0 + w * 8 + tt, t = tok & 2047;
            const float pos = (float)((lane < 32) ? (t >> 6) : (t & 63));
            const float ang = pos * freq; const float cs = __cosf(ang), sn = __sinf(ang);
            bf16_t* row = P + (size_t)tok * DIN;
            float xv[10];
#pragma unroll
            for (int hh = 0; hh < 10; ++hh) xv[hh] = bf2f(row[hh * 64 + lane]);
#pragma unroll
            for (int hh = 0; hh < 10; ++hh) {
                const float x = xv[hh];
                const float rs = rsqrtf(wave_sum(x * x) * (1.f / 64.f) + EPS);
                const float y = x * rs * (hh < 8 ? gql : gkl);
                const float pr = __shfl_xor(y, 16);
                float o = y * cs + ((lane & 16) ? pr : -pr) * sn;
                if (hh < 8) o *= 0.125f * LOG2E;
                row[hh * 64 + lane] = (bf16_t)(pk2(o, 0.f) & 0xffffu);
            }
        }
        for (int j = 0; j < 8; ++j) {
            const int item = tid + 512 * j, tk = item >> 6, ch8 = item & 63, g = ch8 >> 4, hw = 1 << g;
            const int t = s0 + tk; int lo = t - hw; if (lo < 0) lo = 0; int hi = t + hw; if (hi > SEQ) hi = SEQ;
            const bf16_t* base = P + (size_t)(b * SEQ) * DIN + C_POOL + 8 * ch8;
            float sum[8];
#pragma unroll
            for (int e = 0; e < 8; ++e) sum[e] = 0.f;
            for (int r = lo; r < hi; ++r) { const u32x4 v = *(const u32x4*)(base + (size_t)r * DIN);
                sum[0] += bflo(v.x); sum[1] += bfhi(v.x); sum[2] += bflo(v.y); sum[3] += bfhi(v.y); sum[4] += bflo(v.z); sum[5] += bfhi(v.z); sum[6] += bflo(v.w); sum[7] += bfhi(v.w); }
            const float inv = 1.f / (float)(hi - lo);
            const u32x4 sv = *(const u32x4*)(base + (size_t)t * DIN);
            u32x4 o; o.x = pk2(sum[0] * inv - bflo(sv.x), sum[1] * inv - bfhi(sv.x)); o.y = pk2(sum[2] * inv - bflo(sv.y), sum[3] * inv - bfhi(sv.y));
            o.z = pk2(sum[4] * inv - bflo(sv.z), sum[5] * inv - bfhi(sv.z)); o.w = pk2(sum[6] * inv - bflo(sv.w), sum[7] * inv - bfhi(sv.w));
            *(u32x4*)(DIFF + (size_t)(tok0 + tk) * 512 + 8 * ch8) = o;
        }
        __syncthreads();
        { const int rw = tid >> 2, seg = tid & 3; unsigned pkd[8];
#pragma unroll
          for (int k = 0; k < 8; ++k) pkd[k] = (unsigned)T1[(seg * 16 + 2 * k) * 136 + rw] | ((unsigned)T1[(seg * 16 + 2 * k + 1) * 136 + rw] << 16);
          bf16_t* dst = VAT + ((size_t)(b * 128 + rw)) * SEQ + s0 + seg * 16;
          *(u32x4*)dst = (u32x4){pkd[0], pkd[1], pkd[2], pkd[3]}; *(u32x4*)(dst + 8) = (u32x4){pkd[4], pkd[5], pkd[6], pkd[7]}; }
        { bf16_t* dst = VCT + ((size_t)(b * 512 + tid)) * SEQ + s0;
#pragma unroll
          for (int q4 = 0; q4 < 8; ++q4) { unsigned pkd[4];
#pragma unroll
            for (int k = 0; k < 4; ++k) pkd[k] = (unsigned)T2[(q4 * 8 + 2 * k) * 520 + tid] | ((unsigned)T2[(q4 * 8 + 2 * k + 1) * 520 + tid] << 16);
            *(u32x4*)(dst + q4 * 8) = (u32x4){pkd[0], pkd[1], pkd[2], pkd[3]}; } }
        __syncthreads();
    }
}

__device__ __forceinline__ void p3_attn(const Ctx& C, int l, int dummy) {
    bf16_t* P = (bf16_t*)(C.ws + WS_BIG);
    const bf16_t* VAT = (const bf16_t*)(C.ws + WS_VAT);
    int tid_ = threadIdx.x; asm volatile("" : "+v"(tid_)); const int tid = tid_, lane = tid & 63, wave = __builtin_amdgcn_readfirstlane(tid >> 6); (void)tid; (void)lane; (void)wave;
    const int w = wave, hi = lane >> 5, l32 = lane & 31;
    const float Mb = 8.f * LOG2E * wave_max(fabsf(C.in[7][l * 64 + lane])) * wave_max(fabsf(C.in[8][l * 64 + lane]));
    const int pm = (l32 & ~12) | ((l32 & 4) << 1) | ((l32 & 8) >> 1);
    bf16_t* Ks = (bf16_t*)C.lds;
    bf16_t* Vs = Ks + 2 * 64 * 72;
    const int sr = tid >> 3, sc = tid & 7;
    for (int u = blockIdx.x; u < 1024; u += C.G) {
        const int b = u >> 6, h = (u >> 3) & 7, qb = u & 7, kvh = h >> 2;
        bf16_t* Qrow = P + (size_t)(b * SEQ + qb * 256 + w * 32 + l32) * DIN + h * 64;
        bf16x8 qf[4];
#pragma unroll
        for (int ks = 0; ks < 4; ++ks) qf[ks] = *(const bf16x8*)(Qrow + 16 * ks + 8 * hi);
        const bf16_t* Kg = P + (size_t)(b * SEQ + sr) * DIN + C_KA + kvh * 64 + 8 * sc;
        const bf16_t* Vg = VAT + (size_t)((b * 2 + kvh) * 64 + sr) * SEQ + 8 * sc;
        f32x16 O0, O1;
#pragma unroll
        for (int i = 0; i < 16; ++i) { O0[i] = 0.f; O1[i] = 0.f; }
        float lsum = 0.f;
        u32x4 kreg = *(const u32x4*)Kg, vreg = *(const u32x4*)Vg;
        __syncthreads();
        *(u32x4*)(Ks + sr * 72 + 8 * sc) = kreg; *(u32x4*)(Vs + sr * 72 + 8 * sc) = vreg;
        __syncthreads();
        for (int t = 0; t < 32; ++t) {
            const int buf = t & 1;
            if (t + 1 < 32) { kreg = *(const u32x4*)(Kg + (size_t)(t + 1) * 64 * DIN); vreg = *(const u32x4*)(Vg + (t + 1) * 64); }
            const bf16_t* Kb = Ks + buf * 64 * 72; const bf16_t* Vb = Vs + buf * 64 * 72;
            f32x16 S0, S1;
#pragma unroll
            for (int i = 0; i < 16; ++i) { S0[i] = 0.f; S1[i] = 0.f; }
#pragma unroll
            for (int ks = 0; ks < 4; ++ks) {
                const bf16x8 k0 = *(const bf16x8*)(Kb + pm * 72 + 16 * ks + 8 * hi);
                const bf16x8 k1 = *(const bf16x8*)(Kb + (32 + pm) * 72 + 16 * ks + 8 * hi);
                S0 = __builtin_amdgcn_mfma_f32_32x32x16_bf16(k0, qf[ks], S0, 0, 0, 0);
                S1 = __builtin_amdgcn_mfma_f32_32x32x16_bf16(k1, qf[ks], S1, 0, 0, 0);
            }
            float ls = 0.f;
#pragma unroll
            for (int i = 0; i < 16; ++i) { S0[i] = __builtin_amdgcn_exp2f(S0[i] - Mb); S1[i] = __builtin_amdgcn_exp2f(S1[i] - Mb); ls += S0[i] + S1[i]; }
            lsum += ls;
            bf16x8 p[4];
            { u32x4 a; a.x = pk2(S0[0], S0[1]); a.y = pk2(S0[2], S0[3]); a.z = pk2(S0[4], S0[5]); a.w = pk2(S0[6], S0[7]); p[0] = __builtin_bit_cast(bf16x8, a); }
            { u32x4 a; a.x = pk2(S0[8], S0[9]); a.y = pk2(S0[10], S0[11]); a.z = pk2(S0[12], S0[13]); a.w = pk2(S0[14], S0[15]); p[1] = __builtin_bit_cast(bf16x8, a); }
            { u32x4 a; a.x = pk2(S1[0], S1[1]); a.y = pk2(S1[2], S1[3]); a.z = pk2(S1[4], S1[5]); a.w = pk2(S1[6], S1[7]); p[2] = __builtin_bit_cast(bf16x8, a); }
            { u32x4 a; a.x = pk2(S1[8], S1[9]); a.y = pk2(S1[10], S1[11]); a.z = pk2(S1[12], S1[13]); a.w = pk2(S1[14], S1[15]); p[3] = __builtin_bit_cast(bf16x8, a); }
#pragma unroll
            for (int jj = 0; jj < 4; ++jj) {
                const bf16x8 v0 = *(const bf16x8*)(Vb + l32 * 72 + 16 * jj + 8 * hi);
                const bf16x8 v1 = *(const bf16x8*)(Vb + (32 + l32) * 72 + 16 * jj + 8 * hi);
                O0 = __builtin_amdgcn_mfma_f32_32x32x16_bf16(v0, p[jj], O0, 0, 0, 0);
                O1 = __builtin_amdgcn_mfma_f32_32x32x16_bf16(v1, p[jj], O1, 0, 0, 0);
            }
            if (t + 1 < 32) { *(u32x4*)(Ks + (buf ^ 1) * 64 * 72 + sr * 72 + 8 * sc) = kreg; *(u32x4*)(Vs + (buf ^ 1) * 64 * 72 + sr * 72 + 8 * sc) = vreg; }
            __syncthreads();
        }
        const float inv = 1.f / (lsum + __shfl_xor(lsum, 32));
        bf16_t* Orow = dummy ? ((bf16_t*)C.out + ((size_t)(Qrow - P) & (size_t)0x3ffffc0)) : Qrow;
#pragma unroll
        for (int i4 = 0; i4 < 4; ++i4) {
            u32x2 a; a.x = pk2(O0[4 * i4] * inv, O0[4 * i4 + 1] * inv); a.y = pk2(O0[4 * i4 + 2] * inv, O0[4 * i4 + 3] * inv);
            *(u32x2*)(Orow + 8 * i4 + 4 * hi) = a;
            u32x2 c; c.x = pk2(O1[4 * i4] * inv, O1[4 * i4 + 1] * inv); c.y = pk2(O1[4 * i4 + 2] * inv, O1[4 * i4 + 3] * inv);
            *(u32x2*)(Orow + 32 + 8 * i4 + 4 * hi) = c;
        }
    }
}

__device__ __forceinline__ void p3_natten(const Ctx& C, int l, int dummy) {
    bf16_t* P = (bf16_t*)(C.ws + WS_BIG);
    const bf16_t* VCT = (const bf16_t*)(C.ws + WS_XN + 32 * MiB);
    int tid_ = threadIdx.x; asm volatile("" : "+v"(tid_)); const int tid = tid_, lane = tid & 63, wave = __builtin_amdgcn_readfirstlane(tid >> 6); (void)tid; (void)lane; (void)wave;
    const int h = wave, q = lane & 15, Qr = lane >> 4;
    const float* rpb = C.in[11] + (size_t)(l * 8 + h) * 15 * 31;
    for (int u = blockIdx.x; u < 2048; u += C.G) {
        const int b = u >> 7, r = (u >> 2) & 31, cgp = u & 3, c0 = cgp * 16;
        int kc0 = c0 - 8; kc0 = kc0 < 0 ? 0 : (kc0 > 32 ? 32 : kc0);
        int rs = r - 4; rs = rs < 0 ? 0 : (rs > 24 ? 24 : rs);
        const int c = c0 + q; int cs = c - 8; cs = cs < 0 ? 0 : (cs > 48 ? 48 : cs);
        bf16_t* qrow = P + (size_t)(b * SEQ + r * 64 + c) * DIN + C_QC + h * 64;
        const bf16x8 q0 = *(const bf16x8*)(qrow + 8 * Qr), q1 = *(const bf16x8*)(qrow + 32 + 8 * Qr);
        const int kcolA = 8 * (q >> 2) + (q & 3);
        f32x4 S[8][2];
#pragma unroll
        for (int rr = 0; rr < 8; ++rr) {
#pragma unroll
            for (int a = 0; a < 2; ++a) {
                const bf16_t* kp = P + (size_t)(b * SEQ + (rs + rr) * 64 + kc0 + kcolA + 4 * a) * DIN + C_KC + h * 64 + 8 * Qr;
                const bf16x8 k0 = *(const bf16x8*)kp, k1 = *(const bf16x8*)(kp + 32);
                f32x4 s = {0.f, 0.f, 0.f, 0.f};
                s = __builtin_amdgcn_mfma_f32_16x16x32_bf16(k0, q0, s, 0, 0, 0);
                s = __builtin_amdgcn_mfma_f32_16x16x32_bf16(k1, q1, s, 0, 0, 0);
                S[rr][a] = s;
            }
        }
        float mx = -3.0e38f;
#pragma unroll
        for (int rr = 0; rr < 8; ++rr)
#pragma unroll
            for (int a = 0; a < 2; ++a)
#pragma unroll
                for (int i = 0; i < 4; ++i) {
                    const int kc = kc0 + 8 * Qr + 4 * a + i;
                    const bool ok = (kc >= cs) && (kc < cs + 16);
                    const int dc = ok ? (kc - c + 15) : 0;
                    const float bias = rpb[(rs + rr - r + 7) * 31 + dc];
                    const float s = ok ? (S[rr][a][i] * 0.125f + bias) : -3.0e38f;
                    S[rr][a][i] = s; mx = fmaxf(mx, s);
                }
        mx = fmaxf(mx, __shfl_xor(mx, 16)); mx = fmaxf(mx, __shfl_xor(mx, 32));
        float sum = 0.f;
#pragma unroll
        for (int rr = 0; rr < 8; ++rr)
#pragma unroll
            for (int a = 0; a < 2; ++a)
#pragma unroll
                for (int i = 0; i < 4; ++i) { const float pv = __expf(S[rr][a][i] - mx); S[rr][a][i] = pv; sum += pv; }
        sum += __shfl_xor(sum, 16); sum += __shfl_xor(sum, 32);
        const float inv = 1.f / sum;
        f32x4 O[4];
#pragma unroll
        for (int d = 0; d < 4; ++d) O[d] = (f32x4){0.f, 0.f, 0.f, 0.f};
        const bf16_t* vbase = VCT + (size_t)((b * 8 + h) * 64 + q) * SEQ + kc0 + 8 * Qr;
#pragma unroll
        for (int rr = 0; rr < 8; ++rr) {
            u32x4 pa; pa.x = pk2(S[rr][0][0], S[rr][0][1]); pa.y = pk2(S[rr][0][2], S[rr][0][3]); pa.z = pk2(S[rr][1][0], S[rr][1][1]); pa.w = pk2(S[rr][1][2], S[rr][1][3]);
            const bf16x8 pb = __builtin_bit_cast(bf16x8, pa);
#pragma unroll
            for (int d = 0; d < 4; ++d) {
                const bf16x8 vv = *(const bf16x8*)(vbase + (size_t)(16 * d) * SEQ + (rs + rr) * 64);
                O[d] = __builtin_amdgcn_mfma_f32_16x16x32_bf16(vv, pb, O[d], 0, 0, 0);
            }
        }
        bf16_t* orow = dummy ? ((bf16_t*)C.out + ((size_t)(qrow - P) & (size_t)0x3ffffc0)) : qrow;
#pragma unroll
        for (int d = 0; d < 4; ++d) { u32x2 o; o.x = pk2(O[d][0] * inv, O[d][1] * inv); o.y = pk2(O[d][2] * inv, O[d][3] * inv); *(u32x2*)(orow + 16 * d + 4 * Qr) = o; }
    }
}

__device__ __forceinline__ void unpack8(const u32x4 v, float* f) { f[0] = bflo(v.x); f[1] = bfhi(v.x); f[2] = bflo(v.y); f[3] = bfhi(v.y); f[4] = bflo(v.z); f[5] = bfhi(v.z); f[6] = bflo(v.w); f[7] = bfhi(v.w); }
__device__ __forceinline__ void p8_convact(const Ctx& C, int l) {
    bf16_t* UP = (bf16_t*)(C.ws + WS_BIG);
    const bf16_t* HALO = (const bf16_t*)(C.ws + WS_VAT);
    const float* cw = C.in[15] + (size_t)l * 3 * DUP; const float* cb = C.in[16] + (size_t)l * DUP;
    int tid_ = threadIdx.x; asm volatile("" : "+v"(tid_)); const int tid = tid_, lane = tid & 63, wave = __builtin_amdgcn_readfirstlane(tid >> 6); (void)tid; (void)lane; (void)wave;
    const u32x4 zero = {0u, 0u, 0u, 0u};
    for (int it = blockIdx.x * 512 + tid; it < 512 * 352; it += C.G * 512) {
        const int ch = it / 352, ct = it - ch * 352, f = 8 * ct, row0 = ch * 64;
        float w0v[8], w1v[8], w2v[8], bvv[8], w0g[8], w1g[8], w2g[8], bgg[8];
#pragma unroll
        for (int e = 0; e < 8; ++e) { w0v[e] = cw[f + e]; w1v[e] = cw[DUP + f + e]; w2v[e] = cw[2 * DUP + f + e]; bvv[e] = cb[f + e];
            w0g[e] = cw[DFF + f + e]; w1g[e] = cw[DUP + DFF + f + e]; w2g[e] = cw[2 * DUP + DFF + f + e]; bgg[e] = cb[DFF + f + e]; }
        bf16_t* vp = UP + (size_t)row0 * DUP + f; const bf16_t* gp = vp + DFF;
        const bool first = (row0 & 2047) == 0, last = ((row0 + 64) & 2047) == 0;
        u32x4 pv = first ? zero : *(const u32x4*)(HALO + (size_t)((ch - 1) * 2 + 1) * DFF + f);
        u32x4 pg = first ? zero : *(const u32x4*)(gp - DUP);
        u32x4 cv = *(const u32x4*)vp, cgt = *(const u32x4*)gp;
        for (int r4 = 0; r4 < 64; r4 += 4) {
            u32x4 nv[4], ng[4];
#pragma unroll
            for (int k = 0; k < 4; ++k) {
                const int r = r4 + k + 1;
                if (r < 64) { nv[k] = *(const u32x4*)(vp + (size_t)r * DUP); ng[k] = *(const u32x4*)(gp + (size_t)r * DUP); }
                else { nv[k] = last ? zero : *(const u32x4*)(HALO + (size_t)((ch + 1) * 2) * DFF + f); ng[k] = last ? zero : *(const u32x4*)(gp + (size_t)64 * DUP); }
            }
#pragma unroll
            for (int k = 0; k < 4; ++k) {
                float a[8], bq[8], c[8], ga[8], gb[8], gc[8];
                unpack8(pv, a); unpack8(cv, bq); unpack8(nv[k], c); unpack8(pg, ga); unpack8(cgt, gb); unpack8(ng[k], gc);
                float o[8];
#pragma unroll
                for (int e = 0; e < 8; ++e) {
                    const float val = a[e] * w0v[e] + bq[e] * w1v[e] + c[e] * w2v[e] + bvv[e];
                    const float x = ga[e] * w0g[e] + gb[e] * w1g[e] + gc[e] * w2g[e] + bgg[e];
                    const float t2 = 1.5957691216057308f * (x + 0.044715f * x * x * x);
                    const float ge = x * __builtin_amdgcn_rcpf(1.f + __expf(-t2));
                    o[e] = ge * val;
                }
                u32x4 ov; ov.x = pk2(o[0], o[1]); ov.y = pk2(o[2], o[3]); ov.z = pk2(o[4], o[5]); ov.w = pk2(o[6], o[7]);
                *(u32x4*)(vp + (size_t)(r4 + k) * DUP) = ov;
                pv = cv; pg = cgt; cv = nv[k]; cgt = ng[k];
            }
        }
    }
}

#define XB_TMO      128
#define XB_XCNT(j)  (256  + 64 * (j))
#define XB_XSUB(j)  (1280 + 64 * (j))
#define XB_XGEN(j)  (2304 + 64 * (j))
#define XB_TOP      3328
#define XB_TOPGEN   3392
#define XCD_BAR_WORDS 3456
#define XB_SPIN_CAP (1u << 18)

__device__ __forceinline__ unsigned xb_ld(unsigned* p)              { return __hip_atomic_load(p, __ATOMIC_RELAXED, __HIP_MEMORY_SCOPE_AGENT); }
__device__ __forceinline__ unsigned xb_add(unsigned* p, unsigned v) { return __hip_atomic_fetch_add(p, v, __ATOMIC_RELAXED, __HIP_MEMORY_SCOPE_AGENT); }
__device__ __forceinline__ unsigned xb_xcc_id() { return (unsigned)__builtin_amdgcn_s_getreg((3 << 11) | 20) & 0xFu; }
#define XB_SPIN(cond, bar) do { unsigned _sp = 0; while (cond) { __builtin_amdgcn_s_sleep(1); \
    if ((++_sp & 255u) == 0u) { if (xb_ld(&(bar)[XB_TMO])) break; if (_sp > XB_SPIN_CAP) { atomicAdd(&(bar)[XB_TMO], 1u); break; } } } } while (0)

struct XcdBarrier {
    unsigned* bar; unsigned x;
    volatile LAS unsigned* st;
};

__device__ __forceinline__ XcdBarrier xcd_barrier_post(unsigned* bar, volatile LAS unsigned* st) {
    XcdBarrier b; b.bar = bar; b.x = xb_xcc_id(); b.st = st;
    if (threadIdx.x == 0) (void)xb_add(&bar[XB_XCNT(b.x)], 1u);
    return b;
}
__device__ __forceinline__ void xcd_barrier_complete(unsigned* bar, unsigned x, unsigned& nloc, unsigned& nx) {
    const unsigned G = gridDim.x * gridDim.y * gridDim.z;
    unsigned sum, cnt, mine, sp = 0u;
    for (;;) {
        sum = 0u; cnt = 0u; mine = 0u;
#pragma unroll
        for (unsigned j = 0; j < 16; ++j) { const unsigned c = xb_ld(&bar[XB_XCNT(j)]); sum += c; cnt += (c > 0u) ? 1u : 0u; mine = (j == x) ? c : mine; }
        if (sum == G) break;
        __builtin_amdgcn_s_sleep(1);
        if ((++sp & 255u) == 0u) { if (xb_ld(&bar[XB_TMO])) break; if (sp > XB_SPIN_CAP) { atomicAdd(&bar[XB_TMO], 1u); break; } }
    }
    nloc = mine > 0u ? mine : 1u; nx = cnt > 0u ? cnt : 1u;
}

__device__ __forceinline__ void xcd_barrier(const XcdBarrier& b) {
    asm volatile("s_waitcnt vmcnt(0)" ::: "memory");
    __syncthreads();
    if (threadIdx.x == 0) {
        unsigned* bar = b.bar;
        __builtin_amdgcn_s_waitcnt(0);
        unsigned nloc = b.st[0], nx = b.st[1];
        if (nloc == 0u) { xcd_barrier_complete(bar, b.x, nloc, nx); b.st[0] = nloc; b.st[1] = nx; }
        const unsigned old = xb_add(&bar[XB_XSUB(b.x)], 1u);
        const unsigned gen = old / nloc;
        if (old + 1u == (gen + 1u) * nloc) {
            __builtin_amdgcn_fence(__ATOMIC_RELEASE, "agent");
            asm volatile("s_waitcnt vmcnt(0)" ::: "memory");
            const unsigned og = xb_add(&bar[XB_TOP], 1u);
            const unsigned tg = og / nx;
            if (og + 1u == (tg + 1u) * nx) xb_add(&bar[XB_TOPGEN], 1u);
            else XB_SPIN(xb_ld(&bar[XB_TOPGEN]) == tg, bar);
            __builtin_amdgcn_fence(__ATOMIC_ACQUIRE, "agent");
            xb_add(&bar[XB_XGEN(b.x)], 1u);
            asm volatile("s_waitcnt vmcnt(0)" ::: "memory");
        } else {
            XB_SPIN(xb_ld(&bar[XB_XGEN(b.x)]) == gen, bar);
            __builtin_amdgcn_fence(__ATOMIC_ACQUIRE, "agent");
            asm volatile("s_waitcnt vmcnt(0)" ::: "memory");
        }
    }
    __syncthreads();
}

#ifndef GEMM_MASK
#define GEMM_MASK 63
#endif
#define GEMM_CALL1 if ((GEMM_MASK >> 0) & 1)
#define GEMM_CALL2 if ((GEMM_MASK >> 1) & 1)
#define GEMM_CALL3 if ((GEMM_MASK >> 2) & 1)
#define GEMM_CALL4 if ((GEMM_MASK >> 3) & 1)
#define GEMM_CALL5 if ((GEMM_MASK >> 4) & 1)
#define GEMM_CALL6 if ((GEMM_MASK >> 5) & 1)
struct Args { const float* in[18]; float* out; unsigned char* ws; int ph_lo, ph_hi; };
constexpr int N_PHASES = 21;

__global__ void __launch_bounds__(512, 2) fwd_mega(Args args) {
    extern __shared__ __attribute__((aligned(16))) unsigned char lds[];
    cg::grid_group grid = cg::this_grid();
    Ctx C;
#pragma unroll
    for (int i = 0; i < 18; ++i) C.in[i] = args.in[i];
    C.out = args.out; C.ws = args.ws; C.lds = lds; C.G = gridDim.x;
    PG8_LAS unsigned char* ldsg = (PG8_LAS unsigned char*)lds;
    volatile LAS unsigned* bst = (volatile LAS unsigned*)(ldsg + 131072);
    if (threadIdx.x < 64) bst[threadIdx.x] = 0u;
    __syncthreads();
    XcdBarrier xbar = xcd_barrier_post((unsigned*)(args.ws + 4096 * 4), bst);
    bf16_t* Wb = (bf16_t*)(C.ws + WS_W);
    bf16_t* XN = (bf16_t*)(C.ws + WS_XN);
    bf16_t* BIG = (bf16_t*)(C.ws + WS_BIG);
    for (int ph = args.ph_lo; ph < args.ph_hi; ++ph) {
        if (ph == 0) {
#ifndef NO_P0
 p0_prologue(C);
#endif
 }
        else {
            const int l = (ph - 1) / 10, k = (ph - 1) % 10;
            if (k == 0) {
                __syncthreads();
                pg8::Gemm g{XN, Wb + OW_IN + (size_t)l * DIN * 1024, 1024, 1024, 1024};
                pg8::StdSched S{128, 23, C.G, (int)blockIdx.x, (size_t)256 * 1024 * 2, (size_t)256 * 1024 * 2};
                EpiProj E{BIG, C.in[6] + l * 3072};
                GEMM_CALL1 pg8::gemm_phase<EpiProj, pg8::StdSched, true, true>(ldsg, g, S, E);
#if defined(DUP_P1)
                __syncthreads(); pg8::gemm_phase<EpiProj, pg8::StdSched, true, true>(ldsg, g, S, E);
#endif
            } else if (k == 1) {
                __syncthreads();
#ifndef NO_P2
                p2_prep(C, l);
#endif
            } else if (k == 2) {
                __syncthreads();
#ifndef NO_ATT
                p3_attn(C, l, 0);
#if defined(DUP_ATT)
                if (l == 0) { __syncthreads(); p3_attn(C, l, 1); }
#endif
#endif
#ifndef NO_NAT
                p3_natten(C, l, 0);
#if defined(DUP_NAT)
                if (l == 0) p3_natten(C, l, 1);
#endif
#endif
                __syncthreads();
                pg8::Gemm g{(const bf16_t*)(C.ws + WS_XN), Wb + OW_POOL + (size_t)l * 512 * 512, 512, 512, 512};
                pg8::StdSched S{128, 2, C.G, (int)blockIdx.x, (size_t)256 * 512 * 2, (size_t)256 * 512 * 2};
                EpiPlain E{BIG + C_POOL, DIN};
                GEMM_CALL2 pg8::gemm_phase<EpiPlain, pg8::StdSched, true, true>(ldsg, g, S, E);
            } else if (k == 3) {
                __syncthreads();
                pg8::Gemm g{BIG, Wb + OW_BR + (size_t)l * 3 * 1024 * 512, DIN, 512, 512};
                BranchSched S{C.G, (int)blockIdx.x};
                EpiBranch E{BIG, XN};
                GEMM_CALL3 pg8::gemm_phase<EpiBranch, BranchSched, true, true>(ldsg, g, S, E);
            } else if (k == 4) {
                __syncthreads();
                pg8::Gemm g{XN, Wb + OW_OUT + (size_t)l * 1024 * 1024, 1024, 1024, 1024};
                pg8::StdSched S{128, 4, C.G, (int)blockIdx.x, (size_t)256 * 1024 * 2, (size_t)256 * 1024 * 2};
                EpiPlain E{BIG, DM};
                GEMM_CALL4 pg8::gemm_phase<EpiPlain, pg8::StdSched, true, true>(ldsg, g, S, E);
            } else if (k == 5) {
                int tid_ = threadIdx.x; asm volatile("" : "+v"(tid_)); const int lane = tid_ & 63, gw = blockIdx.x * 8 + __builtin_amdgcn_readfirstlane(tid_ >> 6), NGW = C.G * 8;
                const float* xin = (l == 0) ? C.in[0] : C.out;
                for (int m = gw; m < NTOK; m += NGW)
                    resnorm_row(BIG + (size_t)m * DM, xin + (size_t)m * DM, C.in[2] + l * DM, C.out + (size_t)m * DM, C.in[3] + l * DM, XN + (size_t)m * DM, lane);
            } else if (k == 6) {
                __syncthreads();
                pg8::Gemm g{XN, Wb + OW_UP + (size_t)l * DUP * 1024, 1024, 1024, 1024};
                pg8::StdSched S{128, 22, C.G, (int)blockIdx.x, (size_t)256 * 1024 * 2, (size_t)256 * 1024 * 2};
                EpiUp E{BIG, (bf16_t*)(C.ws + WS_VAT)};
                GEMM_CALL5 pg8::gemm_phase<EpiUp, pg8::StdSched, true, true>(ldsg, g, S, E);
            } else if (k == 7) {
#ifndef NO_P8
                p8_convact(C, l);
#endif
            } else if (k == 8) {
                __syncthreads();
                pg8::Gemm g{BIG, Wb + OW_DN + (size_t)l * 1024 * DFF, DUP, DFF, DFF};
                pg8::StdSched S{128, 4, C.G, (int)blockIdx.x, (size_t)256 * DUP * 2, (size_t)256 * DFF * 2};
                EpiPlain E{XN, DM};
                GEMM_CALL6 pg8::gemm_phase<EpiPlain, pg8::StdSched, true, true>(ldsg, g, S, E);
            } else {
                int tid_ = threadIdx.x; asm volatile("" : "+v"(tid_)); const int lane = tid_ & 63, gw = blockIdx.x * 8 + __builtin_amdgcn_readfirstlane(tid_ >> 6), NGW = C.G * 8;
                const float* gnext = (l == 0) ? (C.in[1] + DM) : nullptr;
                for (int m = gw; m < NTOK; m += NGW)
                    resnorm_row(XN + (size_t)m * DM, C.out + (size_t)m * DM, C.in[4] + l * DM, C.out + (size_t)m * DM, gnext, XN + (size_t)m * DM, lane);
            }
        }
        if (ph + 1 < args.ph_hi) { if (ph == 0) grid.sync(); else xcd_barrier(xbar); }
    }
}

#ifndef MK_N_LAUNCHES
#define MK_N_LAUNCHES 1
#endif
extern "C" void kernel_launch(void* const* d_in, const int* in_sizes, int n_in, void* d_out, int out_size, void* d_ws, size_t ws_size, hipStream_t stream) {
    static int grid = 0;
    if (grid == 0) {
        if (n_in != 18 || out_size != NTOK * DM || ws_size < WS_END) { fprintf(stderr, "kernel_launch: unexpected shapes (n_in %d out %d ws %zu)\n", n_in, out_size, ws_size); grid = -1; return; }
        int dev = 0, cus = 0, per_cu = 0;
        hipGetDevice(&dev); hipDeviceGetAttribute(&cus, hipDeviceAttributeMultiprocessorCount, dev);
        if (hipFuncSetAttribute((const void*)fwd_mega, hipFuncAttributeMaxDynamicSharedMemorySize, LDS_BYTES) != hipSuccess) { fprintf(stderr, "kernel_launch: hipFuncSetAttribute failed\n"); grid = -1; return; }
        if (hipOccupancyMaxActiveBlocksPerMultiprocessor(&per_cu, (const void*)fwd_mega, 512, LDS_BYTES) != hipSuccess || per_cu < 1) { fprintf(stderr, "kernel_launch: occupancy query says %d\n", per_cu); per_cu = 1; }
        (void)hipGetLastError();
        grid = cus;
    }
    if (grid < 0) return;
    if (hipMemsetAsync(d_ws, 0, 1 << 20, stream) != hipSuccess) { fprintf(stderr, "kernel_launch: memset failed\n"); return; }
    Args a{};
    for (int i = 0; i < 18; ++i) a.in[i] = (const float*)d_in[i];
    a.out = (float*)d_out; a.ws = (unsigned char*)d_ws;
    if (MK_N_LAUNCHES == 1) {
        a.ph_lo = 0; a.ph_hi = N_PHASES;
        void* kargs[] = {&a};
        hipError_t e = hipLaunchCooperativeKernel((const void*)fwd_mega, dim3(grid), dim3(512), kargs, LDS_BYTES, stream);
        if (e != hipSuccess) fprintf(stderr, "cooperative launch failed: %s (grid %d)\n", hipGetErrorString(e), grid);
    } else {
        for (int ph = 0; ph < N_PHASES; ++ph) { a.ph_lo = ph; a.ph_hi = ph + 1; hipLaunchKernelGGL(fwd_mega, dim3(grid), dim3(512), LDS_BYTES, stream, a); }
    }
}
```

```cpp
#include <hip/hip_runtime.h>
#include <hip/hip_cooperative_groups.h>
#include <cstdio>
#include <cstdint>
namespace cg = cooperative_groups;

namespace pg8 {
#define PG8_LAS __attribute__((address_space(3)))
typedef unsigned short bf16_t;
typedef short bf16x8 __attribute__((ext_vector_type(8)));
typedef float f32x4 __attribute__((ext_vector_type(4)));
typedef unsigned u32x4 __attribute__((ext_vector_type(4)));
constexpr int BM = 256, BK = 64, HALF = 128, HTB = HALF * BK * 2, STAGE_BYTES = 8 * HTB, NXCD = 8, WGM = 8;

__host__ __device__ __forceinline__ int lds_byte(int r, int c) { const int st = (r >> 4) * 2 + (c >> 5), rr = r & 15, cc = c & 31, ob = rr * 64 + cc * 2; return st * 1024 + (ob ^ (((ob >> 9) & 1) << 5)); }
__host__ __device__ __forceinline__ void stage_rc(int b, int& R, int& C) { const int st = b / 1024, sb = b % 1024, swz = sb ^ (((sb >> 9) & 1) << 5); R = (st >> 1) * 16 + swz / 64; C = (st & 1) * 32 + (swz % 64) / 2; }
__host__ __device__ __forceinline__ int perm32(int rho) { const int n = rho >> 4, i = rho & 15; return 8 * (i >> 2) + 4 * n + (i & 3); }

struct Unit { int pm, pn, n; size_t aoff, boff; };
struct Gemm { const bf16_t* A; const bf16_t* Bt; int lda, ldb, K; };

__device__ __forceinline__ void tile_of(int L, int nM, int nN, int& pm, int& pn) {
    const int nwg = nM * nN; int wgid = L; { const int q = nwg / NXCD, r = nwg % NXCD, xcd = wgid % NXCD, off = wgid / NXCD; wgid = (xcd < r ? xcd * (q + 1) : r * (q + 1) + (xcd - r) * q) + off; }
    const int nig = WGM * nN, gid = wgid / nig, fm = gid * WGM, gsz = (nM - fm) < WGM ? (nM - fm) : WGM;
    pm = fm + ((wgid % nig) % gsz); pn = (wgid % nig) / gsz;
}
struct StdSched {
    int nM, nN, G, c; size_t astep, bstep;
    __device__ __forceinline__ bool next(int i, Unit& u) const {
        const long L = (long)i * G + c; if (L >= (long)nM * nN) return false;
        tile_of((int)L, nM, nN, u.pm, u.pn); u.n = 0; u.aoff = (size_t)u.pm * astep; u.boff = (size_t)u.pn * bstep; return true;
    }
    __device__ __forceinline__ void a_ready(const Unit&) const {}
    __device__ __forceinline__ void done(const Unit&) const {}
};
__device__ __forceinline__ unsigned cvt_pk_bf16(float lo, float hi) { unsigned r; asm volatile("v_cvt_pk_bf16_f32 %0, %1, %2" : "=v"(r) : "v"(lo), "v"(hi)); return r; }
template <class Epi, class Sched, bool ALIGN_EPI = false, bool SP2 = false>
__device__ __forceinline__ void gemm_phase(PG8_LAS unsigned char* lds, const Gemm g, const Sched& S, const Epi& E) {
    int tid_ = threadIdx.x; asm volatile("" : "+v"(tid_));
    const int tid = tid_, wid = __builtin_amdgcn_readfirstlane(tid >> 6), lane = tid & 63, wr = wid >> 2, wc = wid & 3, fr = lane & 15, fq = lane >> 4;
    const int K = g.K, nt = K / BK;
    unsigned voffA[2], voffB[2];
#pragma unroll
    for (int i = 0; i < 2; ++i) { int R, C; stage_rc(tid * 16 + i * 8192, R, C); const int Rb = Epi::PERM ? ((R & ~31) + perm32(R & 31)) : R;
        voffA[i] = (unsigned)(R * g.lda + C) * 2u; voffB[i] = (unsigned)(Rb * g.ldb + C) * 2u; }
    const size_t kstep = (size_t)(BK * 2);
    const size_t hstepA = (size_t)HALF * g.lda * 2, hstepB = (size_t)HALF * g.ldb * 2;
    const unsigned ldsw = (unsigned)wid * 1024u;
    const int aoff = lds_byte(wr * 64 + fr, fq * 8), boff = lds_byte(wc * 32 + fr, fq * 8);
#define PG8_SA(b, h) (((b) * 2 + (h)) * HTB)
#define PG8_SB(b, h) ((4 + (b) * 2 + (h)) * HTB)
#define PG8_STAGE(bufoff, gbase, voff) do { _Pragma("unroll") for (int _i = 0; _i < 2; ++_i) \
        __builtin_amdgcn_global_load_lds((const unsigned*)((const char*)(gbase) + (voff)[_i]), (PG8_LAS unsigned*)(lds + (bufoff) + ldsw + _i * 8192), 16, 0, 0); } while (0)
#define PG8_LDA(dst, b, h) do { _Pragma("unroll") for (int m = 0; m < 4; ++m) _Pragma("unroll") for (int k = 0; k < 2; ++k) dst[m][k] = *(const PG8_LAS bf16x8*)(lds + PG8_SA(b, h) + aoff + m * 2048 + k * 1024); } while (0)
#define PG8_LDB(dst, b, h) do { _Pragma("unroll") for (int n = 0; n < 2; ++n) _Pragma("unroll") for (int k = 0; k < 2; ++k) dst[n][k] = *(const PG8_LAS bf16x8*)(lds + PG8_SB(b, h) + boff + n * 2048 + k * 1024); } while (0)
#define PG8_MMA(ai, bj, At, Bt) do { __builtin_amdgcn_s_setprio(1); _Pragma("unroll") for (int m = 0; m < 4; ++m) _Pragma("unroll") for (int n = 0; n < 2; ++n) _Pragma("unroll") for (int k = 0; k < 2; ++k) \
        acc[ai][bj][m][n] = __builtin_amdgcn_mfma_f32_16x16x32_bf16(Bt[n][k], At[m][k], acc[ai][bj][m][n], 0, 0, 0); __builtin_amdgcn_s_setprio(0); } while (0)
#define PG8_WAIT_V(n) asm volatile("s_waitcnt vmcnt(" #n ")" ::: "memory")
#define PG8_WAIT_L(n) asm volatile("s_waitcnt lgkmcnt(" #n ")" ::: "memory")
#define PG8_BAR __builtin_amdgcn_s_barrier()
#define PG8_SCHED __builtin_amdgcn_sched_barrier(0)
    Unit cur, nxt; int ui = 0;
    if (!S.next(0, cur)) return;
    f32x4 acc[2][2][4][2];
#pragma unroll
    for (int a = 0; a < 2; ++a)
#pragma unroll
        for (int b = 0; b < 2; ++b)
#pragma unroll
            for (int m = 0; m < 4; ++m)
#pragma unroll
                for (int n = 0; n < 2; ++n) acc[a][b][m][n] = (f32x4){0.f, 0.f, 0.f, 0.f};
    bf16x8 At[4][2], B0[2][2], B1[2][2];
    const char* cA = (const char*)g.A + cur.aoff; const char* cB = (const char*)g.Bt + cur.boff;
    S.a_ready(cur);
    if constexpr (SP2) {
        PG8_STAGE(PG8_SB(0, 0), cB, voffB); PG8_STAGE(PG8_SB(0, 1), cB + hstepB, voffB); PG8_STAGE(PG8_SA(0, 0), cA, voffA); PG8_STAGE(PG8_SA(0, 1), cA + hstepA, voffA);
        if (wr == 1) PG8_BAR;
        PG8_WAIT_V(2); PG8_BAR;
        PG8_STAGE(PG8_SB(1, 0), cB + kstep, voffB); PG8_STAGE(PG8_SA(1, 0), cA + kstep, voffA); PG8_STAGE(PG8_SB(1, 1), cB + hstepB + kstep, voffB);
        PG8_WAIT_V(6); PG8_BAR;
    } else {
        PG8_STAGE(PG8_SB(0, 0), cB, voffB); PG8_STAGE(PG8_SA(0, 0), cA, voffA); PG8_STAGE(PG8_SB(0, 1), cB + hstepB, voffB); PG8_STAGE(PG8_SA(0, 1), cA + hstepA, voffA);
        if (wr == 1) PG8_BAR;
        PG8_WAIT_V(4); PG8_BAR;
        PG8_STAGE(PG8_SB(1, 0), cB + kstep, voffB); PG8_STAGE(PG8_SA(1, 0), cA + kstep, voffA); PG8_STAGE(PG8_SB(1, 1), cB + hstepB + kstep, voffB);
        PG8_WAIT_V(6); PG8_BAR;
    }
    for (;;) {
        const bool has_next = S.next(ui + 1, nxt);
        const char* nA = has_next ? (const char*)g.A + nxt.aoff : cA; const char* nB = has_next ? (const char*)g.Bt + nxt.boff : cB;
        for (int t = 0; t < nt; t += 2) {
            const bool last = (t == nt - 2);
            const char* a1 = cA + (size_t)(t + 1) * kstep;
            const char* a2 = last ? nA : cA + (size_t)(t + 2) * kstep; const char* b2 = last ? nB : cB + (size_t)(t + 2) * kstep;
            const char* a3 = a2 + kstep; const char* b3 = b2 + kstep;
            if (last && has_next) S.a_ready(nxt);
            if constexpr (SP2) {
            PG8_LDB(B0, 0, 0); PG8_LDB(B1, 0, 1); PG8_SCHED; PG8_LDA(At, 0, 0); PG8_STAGE(PG8_SA(1, 1), a1 + hstepA, voffA);
            PG8_WAIT_V(8); PG8_WAIT_L(0); PG8_BAR; PG8_MMA(0, 0, At, B0); PG8_MMA(0, 1, At, B1); PG8_BAR; PG8_SCHED;
            PG8_LDA(At, 0, 1); PG8_STAGE(PG8_SB(0, 0), b2, voffB); PG8_STAGE(PG8_SB(0, 1), b2 + hstepB, voffB); PG8_STAGE(PG8_SA(0, 0), a2, voffA);
            PG8_WAIT_V(8); PG8_WAIT_L(0); PG8_BAR; PG8_MMA(1, 0, At, B0); PG8_MMA(1, 1, At, B1); PG8_BAR; PG8_SCHED;
            PG8_LDB(B0, 1, 0); PG8_LDB(B1, 1, 1); PG8_SCHED; PG8_LDA(At, 1, 0); PG8_STAGE(PG8_SA(0, 1), a2 + hstepA, voffA);
            PG8_WAIT_V(8); PG8_WAIT_L(0); PG8_BAR; PG8_MMA(0, 0, At, B0); PG8_MMA(0, 1, At, B1); PG8_BAR; PG8_SCHED;
            PG8_LDA(At, 1, 1); PG8_STAGE(PG8_SB(1, 0), b3, voffB); PG8_STAGE(PG8_SB(1, 1), b3 + hstepB, voffB); PG8_STAGE(PG8_SA(1, 0), a3, voffA);
            PG8_WAIT_V(8); PG8_WAIT_L(0); PG8_BAR; PG8_MMA(1, 0, At, B0); PG8_MMA(1, 1, At, B1); PG8_BAR; PG8_SCHED;
            } else {
            PG8_LDB(B0, 0, 0); PG8_SCHED; PG8_LDA(At, 0, 0); PG8_STAGE(PG8_SA(1, 1), a1 + hstepA, voffA);
            PG8_WAIT_L(8); PG8_BAR; PG8_WAIT_L(0); PG8_MMA(0, 0, At, B0); PG8_BAR; PG8_SCHED;
            PG8_LDB(B1, 0, 1); PG8_STAGE(PG8_SB(0, 0), b2, voffB);
            PG8_BAR; PG8_WAIT_L(0); PG8_MMA(0, 1, At, B1); PG8_BAR;
            PG8_LDA(At, 0, 1); PG8_STAGE(PG8_SA(0, 0), a2, voffA);
            PG8_BAR; PG8_WAIT_L(0); PG8_MMA(1, 0, At, B0); PG8_BAR; PG8_SCHED;
            PG8_STAGE(PG8_SB(0, 1), b2 + hstepB, voffB);
            PG8_WAIT_V(6); PG8_BAR; PG8_MMA(1, 1, At, B1); PG8_BAR;
            PG8_LDB(B0, 1, 0); PG8_SCHED; PG8_LDA(At, 1, 0); PG8_STAGE(PG8_SA(0, 1), a2 + hstepA, voffA);
            PG8_WAIT_L(8); PG8_BAR; PG8_WAIT_L(0); PG8_MMA(0, 0, At, B0); PG8_BAR; PG8_SCHED;
            PG8_LDB(B1, 1, 1); PG8_STAGE(PG8_SB(1, 0), b3, voffB);
            PG8_BAR; PG8_WAIT_L(0); PG8_MMA(0, 1, At, B1); PG8_BAR;
            PG8_LDA(At, 1, 1); PG8_STAGE(PG8_SA(1, 0), a3, voffA);
            PG8_BAR; PG8_WAIT_L(0); PG8_MMA(1, 0, At, B0); PG8_BAR; PG8_SCHED;
            PG8_STAGE(PG8_SB(1, 1), b3 + hstepB, voffB);
            PG8_WAIT_V(6); PG8_BAR; PG8_MMA(1, 1, At, B1); PG8_BAR;
            }
        }
        if constexpr (ALIGN_EPI) { if (wr == 0) PG8_BAR; }
        bool fin_ = true;
        if constexpr (Epi::KEEP) { fin_ = E.run(acc, cur, wr, wc, fr, fq); } else if constexpr (!Epi::AFTER_DRAIN) { E(acc, cur, wr, wc, fr, fq); S.done(cur); }
        if (!has_next) break;
        if (fin_) {
#pragma unroll
        for (int a = 0; a < 2; ++a)
#pragma unroll
            for (int b = 0; b < 2; ++b)
#pragma unroll
                for (int m = 0; m < 4; ++m)
#pragma unroll
                    for (int n = 0; n < 2; ++n) acc[a][b][m][n] = (f32x4){0.f, 0.f, 0.f, 0.f};
        }
        cur = nxt; cA = nA; cB = nB; ++ui;
        if constexpr (ALIGN_EPI) { if (wr == 1) PG8_BAR; }
    }
    PG8_WAIT_V(0);
    if constexpr (!ALIGN_EPI) { if (wr == 0) PG8_BAR; }
    PG8_BAR;
    if constexpr (Epi::AFTER_DRAIN) { E.fused(acc, cur, wr, wc, fr, fq, lds, wid, lane); S.done(cur); }
#undef PG8_SA
#undef PG8_SB
#undef PG8_STAGE
#undef PG8_LDA
#undef PG8_LDB
#undef PG8_MMA
#undef PG8_WAIT_V
#undef PG8_WAIT_L
#undef PG8_BAR
#undef PG8_SCHED
}
}

typedef unsigned short bf16_t;
typedef short bf16x8 __attribute__((ext_vector_type(8)));
typedef float f32x4 __attribute__((ext_vector_type(4)));
typedef float f32x16 __attribute__((ext_vector_type(16)));
typedef unsigned u32x4 __attribute__((ext_vector_type(4)));
typedef unsigned u32x2 __attribute__((ext_vector_type(2)));
#define LAS __attribute__((address_space(3)))

constexpr int NTOK = 32768, DM = 1024, SEQ = 2048, DIN = 5888, DFF = 2816, DUP = 5632;
constexpr int C_KA = 512, C_VA = 640, C_POOL = 768, C_QC = 1280, C_KC = 1792, C_VC = 2304, C_GATE = 2816;
constexpr float EPS = 1e-6f, LOG2E = 1.4426950408889634f;
constexpr size_t MiB = (size_t)1 << 20;
constexpr size_t WS_W = 1 * MiB;
constexpr size_t WS_XN = 68 * MiB;
constexpr size_t WS_BIG = 132 * MiB;
constexpr size_t WS_VAT = 500 * MiB;
constexpr size_t WS_END = 511 * MiB;
constexpr size_t OW_IN = 0, OW_BR = 12058624, OW_OUT = 15204352, OW_UP = 17301504, OW_DN = 28835840, OW_POOL = 34603008;
constexpr int LDS_BYTES = 131072 + 1024;

__device__ __forceinline__ float bf2f(unsigned v) { return __uint_as_float(v << 16); }
__device__ __forceinline__ float bflo(unsigned u) { return __uint_as_float(u << 16); }
__device__ __forceinline__ float bfhi(unsigned u) { return __uint_as_float(u & 0xffff0000u); }
__device__ __forceinline__ unsigned pk2(float lo, float hi) { return pg8::cvt_pk_bf16(lo, hi); }
__device__ __forceinline__ float wave_sum(float v) {
#pragma unroll
    for (int o = 1; o < 64; o <<= 1) v += __shfl_xor(v, o);
    return v;
}
__device__ __forceinline__ float wave_max(float v) {
#pragma unroll
    for (int o = 1; o < 64; o <<= 1) v = fmaxf(v, __shfl_xor(v, o));
    return v;
}

struct EpiPlain {
    static constexpr bool PERM = true, AFTER_DRAIN = false, KEEP = false;
    bf16_t* O; int ldc;
    __device__ __forceinline__ void operator()(const f32x4 (&acc)[2][2][4][2], const pg8::Unit& u, int wr, int wc, int fr, int fq) const {
        const int row0 = u.pm * 256 + wr * 64 + fr, col0 = u.pn * 256 + wc * 32 + 8 * fq;
#pragma unroll
        for (int ai = 0; ai < 2; ++ai)
#pragma unroll
            for (int m = 0; m < 4; ++m) { bf16_t* rowp = O + (size_t)(row0 + ai * 128 + m * 16) * ldc + col0;
#pragma unroll
                for (int bj = 0; bj < 2; ++bj) { const f32x4 v0 = acc[ai][bj][m][0], v1 = acc[ai][bj][m][1];
                    u32x4 w; w.x = pk2(v0[0], v0[1]); w.y = pk2(v0[2], v0[3]); w.z = pk2(v1[0], v1[1]); w.w = pk2(v1[2], v1[3]);
                    *(u32x4*)(rowp + bj * 128) = w; } }
    }
};
struct EpiProj {
    static constexpr bool PERM = true, AFTER_DRAIN = false, KEEP = false;
    bf16_t* O; const float* bgate;
    __device__ __forceinline__ void operator()(const f32x4 (&acc)[2][2][4][2], const pg8::Unit& u, int wr, int wc, int fr, int fq) const {
        const int row0 = u.pm * 256 + wr * 64 + fr, col0 = u.pn * 256 + wc * 32 + 8 * fq;
        const bool gate = (u.pn >= 11);
        f32x4 bv[2][2];
#pragma unroll
        for (int bj = 0; bj < 2; ++bj)
#pragma unroll
            for (int n = 0; n < 2; ++n) bv[bj][n] = gate ? *(const f32x4*)(bgate + (col0 - C_GATE) + bj * 128 + 4 * n) : (f32x4){0.f, 0.f, 0.f, 0.f};
#pragma unroll
        for (int ai = 0; ai < 2; ++ai)
#pragma unroll
            for (int m = 0; m < 4; ++m) { bf16_t* rowp = O + (size_t)(row0 + ai * 128 + m * 16) * DIN + col0;
#pragma unroll
                for (int bj = 0; bj < 2; ++bj) { f32x4 v0 = acc[ai][bj][m][0], v1 = acc[ai][bj][m][1];
                    if (gate) {
#pragma unroll
                        for (int j = 0; j < 4; ++j) { v0[j] = __builtin_amdgcn_rcpf(1.f + __expf(-(v0[j] + bv[bj][0][j]))); v1[j] = __builtin_amdgcn_rcpf(1.f + __expf(-(v1[j] + bv[bj][1][j]))); }
                    }
                    u32x4 w; w.x = pk2(v0[0], v0[1]); w.y = pk2(v0[2], v0[3]); w.z = pk2(v1[0], v1[1]); w.w = pk2(v1[2], v1[3]);
                    *(u32x4*)(rowp + bj * 128) = w; } }
    }
};
struct EpiBranch {
    static constexpr bool PERM = true, AFTER_DRAIN = false, KEEP = true;
    const bf16_t* P; bf16_t* MG;
    __device__ __forceinline__ bool run(f32x4 (&acc)[2][2][4][2], const pg8::Unit& u, int wr, int wc, int fr, int fq) const {
        const int row0 = u.pm * 256 + wr * 64 + fr, col0 = u.pn * 256 + wc * 32 + 8 * fq;
#pragma unroll
        for (int ai = 0; ai < 2; ++ai)
#pragma unroll
            for (int m = 0; m < 4; ++m) { const size_t r = (size_t)(row0 + ai * 128 + m * 16);
#pragma unroll
                for (int bj = 0; bj < 2; ++bj) { const int c = col0 + bj * 128;
                    const bf16_t* gp = P + r * DIN + C_GATE + u.n * 1024 + c;
                    const u32x4 gt = *(const u32x4*)gp;
                    float g[8]; g[0] = bflo(gt.x); g[1] = bfhi(gt.x); g[2] = bflo(gt.y); g[3] = bfhi(gt.y); g[4] = bflo(gt.z); g[5] = bfhi(gt.z); g[6] = bflo(gt.w); g[7] = bfhi(gt.w);
                    if (u.n > 0) {
#pragma unroll
                        for (int e = 0; e < 8; ++e) g[e] = fmaxf(g[e], 1e-6f);
                    }
                    if (u.n < 2) { const u32x4 gn = *(const u32x4*)(gp + 1024);
                        float h[8]; h[0] = bflo(gn.x); h[1] = bfhi(gn.x); h[2] = bflo(gn.y); h[3] = bfhi(gn.y); h[4] = bflo(gn.z); h[5] = bfhi(gn.z); h[6] = bflo(gn.w); h[7] = bfhi(gn.w);
#pragma unroll
                        for (int e = 0; e < 8; ++e) g[e] = g[e] * __builtin_amdgcn_rcpf(fmaxf(h[e], 1e-6f));
                    }
                    f32x4 a0 = acc[ai][bj][m][0], a1 = acc[ai][bj][m][1];
                    a0[0] *= g[0]; a0[1] *= g[1]; a0[2] *= g[2]; a0[3] *= g[3]; a1[0] *= g[4]; a1[1] *= g[5]; a1[2] *= g[6]; a1[3] *= g[7];
                    if (u.n < 2) { acc[ai][bj][m][0] = a0; acc[ai][bj][m][1] = a1; }
                    else { u32x4 w; w.x = pk2(a0[0], a0[1]); w.y = pk2(a0[2], a0[3]); w.z = pk2(a1[0], a1[1]); w.w = pk2(a1[2], a1[3]);
                        *(u32x4*)(MG + r * DM + c) = w; } } }
        return u.n == 2;
    }
};
struct BranchSched {
    int G, c;
    __device__ __forceinline__ bool next(int i, pg8::Unit& u) const {
        const int t = i / 3, n = i - 3 * t; const long L = (long)t * G + c; if (L >= 512) return false;
        pg8::tile_of((int)L, 128, 4, u.pm, u.pn); u.n = n;
        const int colA = (n == 0) ? 0 : (n == 1 ? C_POOL : C_QC);
        u.aoff = ((size_t)u.pm * 256 * DIN + colA) * 2; u.boff = ((size_t)(n * 1024 + u.pn * 256) * 512) * 2; return true;
    }
    __device__ __forceinline__ void a_ready(const pg8::Unit&) const {}
    __device__ __forceinline__ void done(const pg8::Unit&) const {}
};
struct EpiUp {
    static constexpr bool PERM = true, AFTER_DRAIN = false, KEEP = false;
    bf16_t* O; bf16_t* HALO;
    __device__ __forceinline__ void operator()(const f32x4 (&acc)[2][2][4][2], const pg8::Unit& u, int wr, int wc, int fr, int fq) const {
        const int row0 = u.pm * 256 + wr * 64 + fr, col0 = u.pn * 256 + wc * 32 + 8 * fq;
        const bool val = (u.pn < 11);
#pragma unroll
        for (int ai = 0; ai < 2; ++ai)
#pragma unroll
            for (int m = 0; m < 4; ++m) { bf16_t* rowp = O + (size_t)(row0 + ai * 128 + m * 16) * DUP + col0;
#pragma unroll
                for (int bj = 0; bj < 2; ++bj) { const f32x4 v0 = acc[ai][bj][m][0], v1 = acc[ai][bj][m][1];
                    u32x4 w; w.x = pk2(v0[0], v0[1]); w.y = pk2(v0[2], v0[3]); w.z = pk2(v1[0], v1[1]); w.w = pk2(v1[2], v1[3]);
                    *(u32x4*)(rowp + bj * 128) = w;
                    if (val && (m & 1) == 0 && fr == 0)  *(u32x4*)(HALO + ((size_t)((u.pm * 8 + ai * 4 + wr * 2 + (m >> 1)) * 2 + 0)) * DFF + col0 + bj * 128) = w;
                    if (val && (m & 1) == 1 && fr == 15) *(u32x4*)(HALO + ((size_t)((u.pm * 8 + ai * 4 + wr * 2 + (m >> 1)) * 2 + 1)) * DFF + col0 + bj * 128) = w; } }
    }
};

struct Ctx {
    const float* in[18]; float* out; unsigned char* ws; unsigned char* lds; int G;
};

__device__ __forceinline__ void transpose_item(const float* W, int K, int N, bf16_t* WT, float* scr, int item, int lane) {
    const int nblk = N / 32, kb = item / nblk, nb = item % nblk, k0 = 64 * kb, n0 = 32 * nb;
#pragma unroll 8
    for (int i = 0; i < 32; ++i) { const int kk = 2 * i + (lane >> 5); scr[kk * 33 + (lane & 31)] = W[(size_t)(k0 + kk) * N + n0 + (lane & 31)]; }
    asm volatile("s_waitcnt lgkmcnt(0)" ::: "memory");
    const int c = lane & 7;
#pragma unroll
    for (int j = 0; j < 4; ++j) { const int n = (lane >> 3) + 8 * j; const float* s = scr + (8 * c) * 33 + n;
        u32x4 o; o.x = pk2(s[0 * 33], s[1 * 33]); o.y = pk2(s[2 * 33], s[3 * 33]); o.z = pk2(s[4 * 33], s[5 * 33]); o.w = pk2(s[6 * 33], s[7 * 33]);
        *(u32x4*)(WT + (size_t)(n0 + n) * K + k0 + 8 * c) = o; }
    asm volatile("s_waitcnt lgkmcnt(0)" ::: "memory");
}
__device__ __forceinline__ void norm_row(const float* xrow, const float* g, bf16_t* orow, int lane) {
    const f32x4* xr = (const f32x4*)xrow + lane; const f32x4* gr = (const f32x4*)g + lane;
    f32x4 v[4]; float s = 0.f;
#pragma unroll
    for (int j = 0; j < 4; ++j) { v[j] = xr[64 * j]; s += (v[j].x * v[j].x + v[j].y * v[j].y) + (v[j].z * v[j].z + v[j].w * v[j].w); }
    const float rs = rsqrtf(wave_sum(s) * (1.f / DM) + EPS);
    u32x2* o8 = (u32x2*)orow + lane;
#pragma unroll
    for (int j = 0; j < 4; ++j) { const f32x4 gg = gr[64 * j]; u32x2 w; w.x = pk2(v[j].x * rs * gg.x, v[j].y * rs * gg.y); w.y = pk2(v[j].z * rs * gg.z, v[j].w * rs * gg.w); o8[64 * j] = w; }
}
__device__ __forceinline__ void resnorm_row(const bf16_t* src, const float* xin, const float* gpost, float* xo, const float* gnext, bf16_t* xn, int lane) {
    const u32x2* sr = (const u32x2*)src + lane; const f32x4* xr = (const f32x4*)xin + lane; const f32x4* gp = (const f32x4*)gpost + lane;
    f32x4 v[4]; float s = 0.f;
#pragma unroll
    for (int j = 0; j < 4; ++j) { const u32x2 w = sr[64 * j]; v[j] = (f32x4){bflo(w.x), bfhi(w.x), bflo(w.y), bfhi(w.y)}; s += (v[j].x * v[j].x + v[j].y * v[j].y) + (v[j].z * v[j].z + v[j].w * v[j].w); }
    const float rs = rsqrtf(wave_sum(s) * (1.f / DM) + EPS);
    float s2 = 0.f;
#pragma unroll
    for (int j = 0; j < 4; ++j) { const f32x4 gg = gp[64 * j], xx = xr[64 * j]; v[j] = xx + v[j] * rs * gg; s2 += (v[j].x * v[j].x + v[j].y * v[j].y) + (v[j].z * v[j].z + v[j].w * v[j].w); }
    f32x4* xw = (f32x4*)xo + lane;
#pragma unroll
    for (int j = 0; j < 4; ++j) xw[64 * j] = v[j];
    if (gnext) {
        const float rs2 = rsqrtf(wave_sum(s2) * (1.f / DM) + EPS);
        const f32x4* gn = (const f32x4*)gnext + lane; u32x2* o8 = (u32x2*)xn + lane;
#pragma unroll
        for (int j = 0; j < 4; ++j) { const f32x4 gg = gn[64 * j]; u32x2 w; w.x = pk2(v[j].x * rs2 * gg.x, v[j].y * rs2 * gg.y); w.y = pk2(v[j].z * rs2 * gg.z, v[j].w * rs2 * gg.w); o8[64 * j] = w; }
    }
}
__device__ __forceinline__ void p0_prologue(const Ctx& C) {
    int tid_ = threadIdx.x; asm volatile("" : "+v"(tid_)); const int tid = tid_, lane = tid & 63, wave = __builtin_amdgcn_readfirstlane(tid >> 6); (void)tid; (void)lane; (void)wave;
    bf16_t* Wb = (bf16_t*)(C.ws + WS_W);
    float* scr = (float*)(C.lds + wave * 16384);
    const int gw = blockIdx.x * 8 + wave, NGW = C.G * 8;
    constexpr int I_IN = 16 * 184, I_BR = 8 * 32, I_OUT = 16 * 32, I_UP = 16 * 176, I_DN = 44 * 32, I_L = I_IN + 3 * I_BR + I_OUT + I_UP + I_DN;
    for (int it = gw; it < 2 * I_L; it += NGW) {
        const int l = it / I_L; int r = it - l * I_L;
        if (r < I_IN) { transpose_item(C.in[5] + (size_t)l * 1024 * DIN, 1024, DIN, Wb + OW_IN + (size_t)l * DIN * 1024, scr, r, lane); continue; } r -= I_IN;
        if (r < 3 * I_BR) { const int n = r / I_BR; transpose_item(C.in[12] + (size_t)(l * 3 + n) * 512 * 1024, 512, 1024, Wb + OW_BR + (size_t)(l * 3 + n) * 1024 * 512, scr, r - n * I_BR, lane); continue; } r -= 3 * I_BR;
        if (r < I_OUT) { transpose_item(C.in[13] + (size_t)l * 1024 * 1024, 1024, 1024, Wb + OW_OUT + (size_t)l * 1024 * 1024, scr, r, lane); continue; } r -= I_OUT;
        if (r < I_UP) { transpose_item(C.in[14] + (size_t)l * 1024 * DUP, 1024, DUP, Wb + OW_UP + (size_t)l * DUP * 1024, scr, r, lane); continue; } r -= I_UP;
        transpose_item(C.in[17] + (size_t)l * DFF * 1024, DFF, 1024, Wb + OW_DN + (size_t)l * 1024 * DFF, scr, r, lane);
    }
    for (int idx = blockIdx.x * 512 + tid; idx < 2 * 512 * 512; idx += C.G * 512) {
        const int l = idx >> 18, n = (idx >> 9) & 511, k = idx & 511, g = n >> 7;
        float v = 0.f;
        if ((k >> 7) == g) v = C.in[9][((size_t)(l * 4 + g) * 128 + (k & 127)) * 128 + (n & 127)] * C.in[10][l * 512 + n];
        Wb[OW_POOL + idx] = (bf16_t)(pk2(v, 0.f) & 0xffffu);
    }
    bf16_t* XN = (bf16_t*)(C.ws + WS_XN);
    for (int m = gw; m < NTOK; m += NGW) norm_row(C.in[0] + (size_t)m * DM, C.in[1], XN + (size_t)m * DM, lane);
}

__device__ __forceinline__ void p2_prep(const Ctx& C, int l) {
    bf16_t* P = (bf16_t*)(C.ws + WS_BIG);
    bf16_t* DIFF = (bf16_t*)(C.ws + WS_XN);
    bf16_t* VCT = (bf16_t*)(C.ws + WS_XN + 32 * MiB);
    bf16_t* VAT = (bf16_t*)(C.ws + WS_VAT);
    bf16_t* T1 = (bf16_t*)C.lds;
    bf16_t* T2 = (bf16_t*)(C.lds + 17408);
    const float* gk = C.in[8] + l * 64;
    int tid_ = threadIdx.x; asm volatile("" : "+v"(tid_)); const int tid = tid_, lane = tid & 63, wave = __builtin_amdgcn_readfirstlane(tid >> 6); (void)tid; (void)lane; (void)wave;
    const int w = wave;
    for (int u = blockIdx.x; u < NTOK / 64; u += C.G) {
        const int tok0 = u * 64, b = tok0 >> 11, s0 = tok0 & 2047;
        for (int i = tid; i < 64 * 16; i += 512) { const int r = i >> 4, c = i & 15; *(u32x4*)(T1 + r * 136 + 8 * c) = *(const u32x4*)(P + (size_t)(tok0 + r) * DIN + C_VA + 8 * c); }
        for (int i = tid; i < 64 * 64; i += 512) { const int r = i >> 6, c = i & 63; *(u32x4*)(T2 + r * 520 + 8 * c) = *(const u32x4*)(P + (size_t)(tok0 + r) * DIN + C_VC + 8 * c); }
        {
            const int j16 = lane & 15, rg = lane >> 4;
            u32x2 raw[4];
#pragma unroll
            for (int ps = 0; ps < 4; ++ps) { const int rw = ps * 4 + rg, tok = tok0 + w * 8 + (rw >> 1); raw[ps] = *(const u32x2*)(P + (size_t)tok * DIN + C_KA + (rw & 1) * 64 + 4 * j16); }
            const f32x4 gk4 = *(const f32x4*)(gk + 4 * j16);
            const bool hi16 = (j16 & 4) != 0;
#pragma unroll
            for (int ps = 0; ps < 4; ++ps) {
                const int rw = ps * 4 + rg, tok = tok0 + w * 8 + (rw >> 1), t = tok & 2047;
                float x[4] = {bflo(raw[ps].x), bfhi(raw[ps].x), bflo(raw[ps].y), bfhi(raw[ps].y)};
                float ss = x[0] * x[0] + x[1] * x[1] + x[2] * x[2] + x[3] * x[3];
                ss += __shfl_xor(ss, 1); ss += __shfl_xor(ss, 2); ss += __shfl_xor(ss, 4); ss += __shfl_xor(ss, 8);
                const float rs = rsqrtf(ss * (1.f / 64.f) + EPS);
                const float pos = (float)((j16 < 8) ? (t >> 6) : (t & 63));
                float o[4];
#pragma unroll
                for (int e = 0; e < 4; ++e) {
                    const int fi = (4 * j16 + e) & 15;
                    const float ang = pos * __builtin_amdgcn_exp2f(-13.287712379549449f * (float)fi * (1.f / 16.f));
                    const float y = x[e] * rs * gk4[e];
                    const float pr = __shfl_xor(y, 4);
                    o[e] = y * __cosf(ang) + (hi16 ? pr : -pr) * __sinf(ang);
                }
                u32x2 ov; ov.x = pk2(o[0], o[1]); ov.y = pk2(o[2], o[3]);
                *(u32x2*)(P + (size_t)tok * DIN + C_KA + (rw & 1) * 64 + 4 * j16) = ov;
            }
        }
        for (int j = 0; j < 8; ++j) {
            const int item = tid + 512 * j, g = item >> 10, rem = item & 1023, tk = rem >> 4, ch8 = 16 * g + (rem & 15), hw = 1 << g;
            const int t = s0 + tk;
            const bf16_t* base = P + (size_t)(b * SEQ) * DIN + C_POOL + 8 * ch8;
            float sum[8];
#pragma unroll
            for (int e = 0; e < 8; ++e) sum[e] = 0.f;
            int cnt = 0;
#pragma unroll
            for (int jj = 0; jj < 16; ++jj) {
                const int r = t - hw + jj;
                if (jj < 2 * hw && r >= 0 && r < SEQ) { const u32x4 v = *(const u32x4*)(base + (size_t)r * DIN); ++cnt;
                    sum[0] += bflo(v.x); sum[1] += bfhi(v.x); sum[2] += bflo(v.y); sum[3] += bfhi(v.y); sum[4] += bflo(v.z); sum[5] += bfhi(v.z); sum[6] += bflo(v.w); sum[7] += bfhi(v.w); }
            }
            const float inv = 1.f / (float)cnt;
            const u32x4 sv = *(const u32x4*)(base + (size_t)t * DIN);
            u32x4 o; o.x = pk2(sum[0] * inv - bflo(sv.x), sum[1] * inv - bfhi(sv.x)); o.y = pk2(sum[2] * inv - bflo(sv.y), sum[3] * inv - bfhi(sv.y));
            o.z = pk2(sum[4] * inv - bflo(sv.z), sum[5] * inv - bfhi(sv.z)); o.w = pk2(sum[6] * inv - bflo(sv.w), sum[7] * inv - bfhi(sv.w));
            *(u32x4*)(DIFF + (size_t)(tok0 + tk) * 512 + 8 * ch8) = o;
        }
        __syncthreads();
        { const int rw = tid >> 2, seg = tid & 3; unsigned pkd[8];
#pragma unroll
          for (int k = 0; k < 8; ++k) pkd[k] = (unsigned)T1[(seg * 16 + 2 * k) * 136 + rw] | ((unsigned)T1[(seg * 16 + 2 * k + 1) * 136 + rw] << 16);
          bf16_t* dst = VAT + ((size_t)(b * 128 + rw)) * SEQ + s0 + seg * 16;
          *(u32x4*)dst = (u32x4){pkd[0], pkd[1], pkd[2], pkd[3]}; *(u32x4*)(dst + 8) = (u32x4){pkd[4], pkd[5], pkd[6], pkd[7]}; }
        { bf16_t* dst = VCT + ((size_t)(b * 512 + tid)) * SEQ + s0;
#pragma unroll
          for (int q4 = 0; q4 < 8; ++q4) { unsigned pkd[4];
#pragma unroll
            for (int k = 0; k < 4; ++k) pkd[k] = (unsigned)T2[(q4 * 8 + 2 * k) * 520 + tid] | ((unsigned)T2[(q4 * 8 + 2 * k + 1) * 520 + tid] << 16);
            *(u32x4*)(dst + q4 * 8) = (u32x4){pkd[0], pkd[1], pkd[2], pkd[3]}; } }
        __syncthreads();
    }
}

__device__ __forceinline__ void p3_attn(const Ctx& C, int l, int dummy) {
    bf16_t* P = (bf16_t*)(C.ws + WS_BIG);
    const bf16_t* VAT = (const bf16_t*)(C.ws + WS_VAT);
    int tid_ = threadIdx.x; asm volatile("" : "+v"(tid_)); const int tid = tid_, lane = tid & 63, wave = __builtin_amdgcn_readfirstlane(tid >> 6); (void)tid; (void)lane; (void)wave;
    const int w = wave, hi = lane >> 5, l32 = lane & 31;
    const float Mb = 8.f * LOG2E * wave_max(fabsf(C.in[7][l * 64 + lane])) * wave_max(fabsf(C.in[8][l * 64 + lane]));
    const int pm = (l32 & ~12) | ((l32 & 4) << 1) | ((l32 & 8) >> 1);
    bf16_t* Ks = (bf16_t*)C.lds;
    bf16_t* Vs = Ks + 2 * 64 * 72;
    const int sr = tid >> 3, sc = tid & 7;
    for (int u = blockIdx.x; u < 1024; u += C.G) {
        int b, h, qb, kvh;
        if (C.G == 256) { const int cx = blockIdx.x & 7, cj = blockIdx.x >> 3, pr = 4 * cx + (cj >> 3); b = pr >> 1; kvh = pr & 1; qb = cj & 7; h = 4 * kvh + (u >> 8); }
        else { b = u >> 6; h = (u >> 3) & 7; qb = u & 7; kvh = h >> 2; }
        bf16_t* Qrow = P + (size_t)(b * SEQ + qb * 256 + w * 32 + l32) * DIN + h * 64;
        bf16x8 qf[4];
        {
            float xq[4][8]; float ss = 0.f;
#pragma unroll
            for (int ks = 0; ks < 4; ++ks) { const u32x4 rq = *(const u32x4*)(Qrow + 16 * ks + 8 * hi);
                xq[ks][0] = bflo(rq.x); xq[ks][1] = bfhi(rq.x); xq[ks][2] = bflo(rq.y); xq[ks][3] = bfhi(rq.y); xq[ks][4] = bflo(rq.z); xq[ks][5] = bfhi(rq.z); xq[ks][6] = bflo(rq.w); xq[ks][7] = bfhi(rq.w);
#pragma unroll
                for (int e = 0; e < 8; ++e) ss += xq[ks][e] * xq[ks][e]; }
            ss += __shfl_xor(ss, 32);
            const float rs = rsqrtf(ss * (1.f / 64.f) + EPS) * (0.125f * LOG2E);
            const int tq = qb * 256 + w * 32 + l32; const float prow = (float)(tq >> 6), pcol = (float)(tq & 63);
            const float* gq = C.in[7] + l * 64 + 8 * hi;
            float oq[4][8];
#pragma unroll
            for (int e = 0; e < 8; ++e) {
                const float fr_ = __builtin_amdgcn_exp2f(-13.287712379549449f * (float)(8 * hi + e) * (1.f / 16.f));
                const float ar = prow * fr_, ac = pcol * fr_;
                const float cr = __cosf(ar), sr_ = __sinf(ar), cc = __cosf(ac), sc_ = __sinf(ac);
                const float y0 = xq[0][e] * rs * gq[e], y1 = xq[1][e] * rs * gq[16 + e], y2 = xq[2][e] * rs * gq[32 + e], y3 = xq[3][e] * rs * gq[48 + e];
                oq[0][e] = y0 * cr - y1 * sr_; oq[1][e] = y0 * sr_ + y1 * cr; oq[2][e] = y2 * cc - y3 * sc_; oq[3][e] = y2 * sc_ + y3 * cc;
            }
#pragma unroll
            for (int ks = 0; ks < 4; ++ks) { u32x4 a; a.x = pk2(oq[ks][0], oq[ks][1]); a.y = pk2(oq[ks][2], oq[ks][3]); a.z = pk2(oq[ks][4], oq[ks][5]); a.w = pk2(oq[ks][6], oq[ks][7]); qf[ks] = __builtin_bit_cast(bf16x8, a); }
        }
        const bf16_t* Kg = P + (size_t)(b * SEQ + sr) * DIN + C_KA + kvh * 64 + 8 * sc;
        const bf16_t* Vg = VAT + (size_t)((b * 2 + kvh) * 64 + sr) * SEQ + 8 * sc;
        f32x16 O0, O1;
#pragma unroll
        for (int i = 0; i < 16; ++i) { O0[i] = 0.f; O1[i] = 0.f; }
        float lsum = 0.f;
        u32x4 kreg = *(const u32x4*)Kg, vreg = *(const u32x4*)Vg;
        u32x4 kr2 = *(const u32x4*)(Kg + (size_t)64 * DIN), vr2 = *(const u32x4*)(Vg + 64);
        __syncthreads();
        *(u32x4*)(Ks + sr * 72 + 8 * sc) = kreg; *(u32x4*)(Vs + sr * 72 + 8 * sc) = vreg;
        __syncthreads();
        kreg = kr2; vreg = vr2;
        for (int t = 0; t < 32; ++t) {
            const int buf = t & 1;
            if (t + 2 < 32) { kr2 = *(const u32x4*)(Kg + (size_t)(t + 2) * 64 * DIN); vr2 = *(const u32x4*)(Vg + (t + 2) * 64); }
            const bf16_t* Kb = Ks + buf * 64 * 72; const bf16_t* Vb = Vs + buf * 64 * 72;
            f32x16 S0, S1;
#pragma unroll
            for (int i = 0; i < 16; ++i) { S0[i] = 0.f; S1[i] = 0.f; }
#pragma unroll
            for (int ks = 0; ks < 4; ++ks) {
                const bf16x8 k0 = *(const bf16x8*)(Kb + pm * 72 + 16 * ks + 8 * hi);
                const bf16x8 k1 = *(const bf16x8*)(Kb + (32 + pm) * 72 + 16 * ks + 8 * hi);
                S0 = __builtin_amdgcn_mfma_f32_32x32x16_bf16(k0, qf[ks], S0, 0, 0, 0);
                S1 = __builtin_amdgcn_mfma_f32_32x32x16_bf16(k1, qf[ks], S1, 0, 0, 0);
            }
            float ls = 0.f;
#pragma unroll
            for (int i = 0; i < 16; ++i) { S0[i] = __builtin_amdgcn_exp2f(S0[i] - Mb); S1[i] = __builtin_amdgcn_exp2f(S1[i] - Mb); ls += S0[i] + S1[i]; }
            lsum += ls;
            bf16x8 p[4];
            { u32x4 a; a.x = pk2(S0[0], S0[1]); a.y = pk2(S0[2], S0[3]); a.z = pk2(S0[4], S0[5]); a.w = pk2(S0[6], S0[7]); p[0] = __builtin_bit_cast(bf16x8, a); }
            { u32x4 a; a.x = pk2(S0[8], S0[9]); a.y = pk2(S0[10], S0[11]); a.z = pk2(S0[12], S0[13]); a.w = pk2(S0[14], S0[15]); p[1] = __builtin_bit_cast(bf16x8, a); }
            { u32x4 a; a.x = pk2(S1[0], S1[1]); a.y = pk2(S1[2], S1[3]); a.z = pk2(S1[4], S1[5]); a.w = pk2(S1[6], S1[7]); p[2] = __builtin_bit_cast(bf16x8, a); }
            { u32x4 a; a.x = pk2(S1[8], S1[9]); a.y = pk2(S1[10], S1[11]); a.z = pk2(S1[12], S1[13]); a.w = pk2(S1[14], S1[15]); p[3] = __builtin_bit_cast(bf16x8, a); }
#pragma unroll
            for (int jj = 0; jj < 4; ++jj) {
                const bf16x8 v0 = *(const bf16x8*)(Vb + l32 * 72 + 16 * jj + 8 * hi);
                const bf16x8 v1 = *(const bf16x8*)(Vb + (32 + l32) * 72 + 16 * jj + 8 * hi);
                O0 = __builtin_amdgcn_mfma_f32_32x32x16_bf16(v0, p[jj], O0, 0, 0, 0);
                O1 = __builtin_amdgcn_mfma_f32_32x32x16_bf16(v1, p[jj], O1, 0, 0, 0);
            }
            if (t + 1 < 32) { *(u32x4*)(Ks + (buf ^ 1) * 64 * 72 + sr * 72 + 8 * sc) = kreg; *(u32x4*)(Vs + (buf ^ 1) * 64 * 72 + sr * 72 + 8 * sc) = vreg; }
            kreg = kr2; vreg = vr2;
            __syncthreads();
        }
        const float inv = 1.f / (lsum + __shfl_xor(lsum, 32));
        bf16_t* Orow = dummy ? ((bf16_t*)C.out + ((size_t)(Qrow - P) & (size_t)0x3ffffc0)) : Qrow;
#pragma unroll
        for (int i4 = 0; i4 < 4; ++i4) {
            u32x2 a; a.x = pk2(O0[4 * i4] * inv, O0[4 * i4 + 1] * inv); a.y = pk2(O0[4 * i4 + 2] * inv, O0[4 * i4 + 3] * inv);
            *(u32x2*)(Orow + 8 * i4 + 4 * hi) = a;
            u32x2 c; c.x = pk2(O1[4 * i4] * inv, O1[4 * i4 + 1] * inv); c.y = pk2(O1[4 * i4 + 2] * inv, O1[4 * i4 + 3] * inv);
            *(u32x2*)(Orow + 32 + 8 * i4 + 4 * hi) = c;
        }
    }
}

__device__ __forceinline__ void p3_natten(const Ctx& C, int l, int dummy) {
    bf16_t* P = (bf16_t*)(C.ws + WS_BIG);
    const bf16_t* VCT = (const bf16_t*)(C.ws + WS_XN + 32 * MiB);
    int tid_ = threadIdx.x; asm volatile("" : "+v"(tid_)); const int tid = tid_, lane = tid & 63, wave = __builtin_amdgcn_readfirstlane(tid >> 6); (void)tid; (void)lane; (void)wave;
    const int h = wave, q = lane & 15, Qr = lane >> 4;
    const float* rpb = C.in[11] + (size_t)(l * 8 + h) * 15 * 31;
    for (int u = blockIdx.x; u < 2048; u += C.G) {
        int b, r, cgp;
        if (C.G == 256) { const int cx = blockIdx.x & 7, idx = (blockIdx.x >> 3) + 32 * (u >> 8); b = 2 * cx + (idx >> 7); r = (idx >> 2) & 31; cgp = idx & 3; }
        else { b = u >> 7; r = (u >> 2) & 31; cgp = u & 3; }
        const int c0 = cgp * 16;
        int kc0 = c0 - 8; kc0 = kc0 < 0 ? 0 : (kc0 > 32 ? 32 : kc0);
        int rs = r - 4; rs = rs < 0 ? 0 : (rs > 24 ? 24 : rs);
        const int c = c0 + q; int cs = c - 8; cs = cs < 0 ? 0 : (cs > 48 ? 48 : cs);
        bf16_t* qrow = P + (size_t)(b * SEQ + r * 64 + c) * DIN + C_QC + h * 64;
        const bf16x8 q0 = *(const bf16x8*)(qrow + 8 * Qr), q1 = *(const bf16x8*)(qrow + 32 + 8 * Qr);
        const int kcolA = 8 * (q >> 2) + (q & 3);
        f32x4 S[8][2];
#pragma unroll
        for (int rr = 0; rr < 8; ++rr) {
#pragma unroll
            for (int a = 0; a < 2; ++a) {
                const bf16_t* kp = P + (size_t)(b * SEQ + (rs + rr) * 64 + kc0 + kcolA + 4 * a) * DIN + C_KC + h * 64 + 8 * Qr;
                const bf16x8 k0 = *(const bf16x8*)kp, k1 = *(const bf16x8*)(kp + 32);
                f32x4 s = {0.f, 0.f, 0.f, 0.f};
                s = __builtin_amdgcn_mfma_f32_16x16x32_bf16(k0, q0, s, 0, 0, 0);
                s = __builtin_amdgcn_mfma_f32_16x16x32_bf16(k1, q1, s, 0, 0, 0);
                S[rr][a] = s;
            }
        }
        float mx = -3.0e38f;
#pragma unroll
        for (int rr = 0; rr < 8; ++rr)
#pragma unroll
            for (int a = 0; a < 2; ++a)
#pragma unroll
                for (int i = 0; i < 4; ++i) {
                    const int kc = kc0 + 8 * Qr + 4 * a + i;
                    const bool ok = (kc >= cs) && (kc < cs + 16);
                    const int dc = ok ? (kc - c + 15) : 0;
                    const float bias = rpb[(rs + rr - r + 7) * 31 + dc];
                    const float s = ok ? (S[rr][a][i] * 0.125f + bias) : -3.0e38f;
                    S[rr][a][i] = s; mx = fmaxf(mx, s);
                }
        mx = fmaxf(mx, __shfl_xor(mx, 16)); mx = fmaxf(mx, __shfl_xor(mx, 32));
        float sum = 0.f;
#pragma unroll
        for (int rr = 0; rr < 8; ++rr)
#pragma unroll
            for (int a = 0; a < 2; ++a)
#pragma unroll
                for (int i = 0; i < 4; ++i) { const float pv = __expf(S[rr][a][i] - mx); S[rr][a][i] = pv; sum += pv; }
        sum += __shfl_xor(sum, 16); sum += __shfl_xor(sum, 32);
        const float inv = 1.f / sum;
        f32x4 O[4];
#pragma unroll
        for (int d = 0; d < 4; ++d) O[d] = (f32x4){0.f, 0.f, 0.f, 0.f};
        const bf16_t* vbase = VCT + (size_t)((b * 8 + h) * 64 + q) * SEQ + kc0 + 8 * Qr;
#pragma unroll
        for (int rr = 0; rr < 8; ++rr) {
            u32x4 pa; pa.x = pk2(S[rr][0][0], S[rr][0][1]); pa.y = pk2(S[rr][0][2], S[rr][0][3]); pa.z = pk2(S[rr][1][0], S[rr][1][1]); pa.w = pk2(S[rr][1][2], S[rr][1][3]);
            const bf16x8 pb = __builtin_bit_cast(bf16x8, pa);
#pragma unroll
            for (int d = 0; d < 4; ++d) {
                const bf16x8 vv = *(const bf16x8*)(vbase + (size_t)(16 * d) * SEQ + (rs + rr) * 64);
                O[d] = __builtin_amdgcn_mfma_f32_16x16x32_bf16(vv, pb, O[d], 0, 0, 0);
            }
        }
        bf16_t* orow = dummy ? ((bf16_t*)C.out + ((size_t)(qrow - P) & (size_t)0x3ffffc0)) : qrow;
#pragma unroll
        for (int d = 0; d < 4; ++d) { u32x2 o; o.x = pk2(O[d][0] * inv, O[d][1] * inv); o.y = pk2(O[d][2] * inv, O[d][3] * inv); *(u32x2*)(orow + 16 * d + 4 * Qr) = o; }
    }
}

__device__ __forceinline__ void unpack8(const u32x4 v, float* f) { f[0] = bflo(v.x); f[1] = bfhi(v.x); f[2] = bflo(v.y); f[3] = bfhi(v.y); f[4] = bflo(v.z); f[5] = bfhi(v.z); f[6] = bflo(v.w); f[7] = bfhi(v.w); }
__device__ __forceinline__ void p8_convact(const Ctx& C, int l) {
    bf16_t* UP = (bf16_t*)(C.ws + WS_BIG);
    const bf16_t* HALO = (const bf16_t*)(C.ws + WS_VAT);
    const float* cw = C.in[15] + (size_t)l * 3 * DUP; const float* cb = C.in[16] + (size_t)l * DUP;
    int tid_ = threadIdx.x; asm volatile("" : "+v"(tid_)); const int tid = tid_, lane = tid & 63, wave = __builtin_amdgcn_readfirstlane(tid >> 6); (void)tid; (void)lane; (void)wave;
    const u32x4 zero = {0u, 0u, 0u, 0u};
    for (int it = blockIdx.x * 512 + tid; it < 1024 * 352; it += C.G * 512) {
        const int ch = it / 352, ct = it - ch * 352, f = 8 * ct, row0 = ch * 32;
        float w0v[8], w1v[8], w2v[8], bvv[8], w0g[8], w1g[8], w2g[8], bgg[8];
#pragma unroll
        for (int e = 0; e < 8; ++e) { w0v[e] = cw[f + e]; w1v[e] = cw[DUP + f + e]; w2v[e] = cw[2 * DUP + f + e]; bvv[e] = cb[f + e];
            w0g[e] = cw[DFF + f + e]; w1g[e] = cw[DUP + DFF + f + e]; w2g[e] = cw[2 * DUP + DFF + f + e]; bgg[e] = cb[DFF + f + e]; }
        bf16_t* vp = UP + (size_t)row0 * DUP + f; const bf16_t* gp = vp + DFF;
        const bool first = (row0 & 2047) == 0, last = ((row0 + 32) & 2047) == 0;
        u32x4 pv = first ? zero : *(const u32x4*)(HALO + (size_t)((ch - 1) * 2 + 1) * DFF + f);
        u32x4 pg = first ? zero : *(const u32x4*)(gp - DUP);
        u32x4 cv = *(const u32x4*)vp, cgt = *(const u32x4*)gp;
        for (int r4 = 0; r4 < 32; r4 += 4) {
            u32x4 nv[4], ng[4];
#pragma unroll
            for (int k = 0; k < 4; ++k) {
                const int r = r4 + k + 1;
                if (r < 32) { nv[k] = *(const u32x4*)(vp + (size_t)r * DUP); ng[k] = *(const u32x4*)(gp + (size_t)r * DUP); }
                else { nv[k] = last ? zero : *(const u32x4*)(HALO + (size_t)((ch + 1) * 2) * DFF + f); ng[k] = last ? zero : *(const u32x4*)(gp + (size_t)32 * DUP); }
            }
#pragma unroll
            for (int k = 0; k < 4; ++k) {
                float a[8], bq[8], c[8], ga[8], gb[8], gc[8];
                unpack8(pv, a); unpack8(cv, bq); unpack8(nv[k], c); unpack8(pg, ga); unpack8(cgt, gb); unpack8(ng[k], gc);
                float o[8];
#pragma unroll
                for (int e = 0; e < 8; ++e) {
                    const float val = a[e] * w0v[e] + bq[e] * w1v[e] + c[e] * w2v[e] + bvv[e];
                    const float x = ga[e] * w0g[e] + gb[e] * w1g[e] + gc[e] * w2g[e] + bgg[e];
                    const float t2 = 1.5957691216057308f * (x + 0.044715f * x * x * x);
                    const float ge = x * __builtin_amdgcn_rcpf(1.f + __expf(-t2));
                    o[e] = ge * val;
                }
                u32x4 ov; ov.x = pk2(o[0], o[1]); ov.y = pk2(o[2], o[3]); ov.z = pk2(o[4], o[5]); ov.w = pk2(o[6], o[7]);
                *(u32x4*)(vp + (size_t)(r4 + k) * DUP) = ov;
                pv = cv; pg = cgt; cv = nv[k]; cgt = ng[k];
            }
        }
    }
}

#define XB_TMO      128
#define XB_XCNT(j)  (256  + 64 * (j))
#define XB_XSUB(j)  (1280 + 64 * (j))
#define XB_XGEN(j)  (2304 + 64 * (j))
#define XB_TOP      3328
#define XB_TOPGEN   3392
#define XCD_BAR_WORDS 3456
#define XB_SPIN_CAP (1u << 18)

__device__ __forceinline__ unsigned xb_ld(unsigned* p)              { return __hip_atomic_load(p, __ATOMIC_RELAXED, __HIP_MEMORY_SCOPE_AGENT); }
__device__ __forceinline__ unsigned xb_add(unsigned* p, unsigned v) { return __hip_atomic_fetch_add(p, v, __ATOMIC_RELAXED, __HIP_MEMORY_SCOPE_AGENT); }
__device__ __forceinline__ unsigned xb_xcc_id() { return (unsigned)__builtin_amdgcn_s_getreg((3 << 11) | 20) & 0xFu; }
#define XB_SPIN(cond, bar) do { unsigned _sp = 0; while (cond) { __builtin_amdgcn_s_sleep(1); \
    if ((++_sp & 255u) == 0u) { if (xb_ld(&(bar)[XB_TMO])) break; if (_sp > XB_SPIN_CAP) { atomicAdd(&(bar)[XB_TMO], 1u); break; } } } } while (0)

struct XcdBarrier {
    unsigned* bar; unsigned x;
    volatile LAS unsigned* st;
};

__device__ __forceinline__ XcdBarrier xcd_barrier_post(unsigned* bar, volatile LAS unsigned* st) {
    XcdBarrier b; b.bar = bar; b.x = xb_xcc_id(); b.st = st;
    if (threadIdx.x == 0) (void)xb_add(&bar[XB_XCNT(b.x)], 1u);
    return b;
}
__device__ __forceinline__ void xcd_barrier_complete(unsigned* bar, unsigned x, unsigned& nloc, unsigned& nx) {
    const unsigned G = gridDim.x * gridDim.y * gridDim.z;
    unsigned sum, cnt, mine, sp = 0u;
    for (;;) {
        sum = 0u; cnt = 0u; mine = 0u;
#pragma unroll
        for (unsigned j = 0; j < 16; ++j) { const unsigned c = xb_ld(&bar[XB_XCNT(j)]); sum += c; cnt += (c > 0u) ? 1u : 0u; mine = (j == x) ? c : mine; }
        if (sum == G) break;
        __builtin_amdgcn_s_sleep(1);
        if ((++sp & 255u) == 0u) { if (xb_ld(&bar[XB_TMO])) break; if (sp > XB_SPIN_CAP) { atomicAdd(&bar[XB_TMO], 1u); break; } }
    }
    nloc = mine > 0u ? mine : 1u; nx = cnt > 0u ? cnt : 1u;
}

__device__ __forceinline__ void xcd_barrier(const XcdBarrier& b) {
    asm volatile("s_waitcnt vmcnt(0)" ::: "memory");
    __syncthreads();
    if (threadIdx.x == 0) {
        unsigned* bar = b.bar;
        __builtin_amdgcn_s_waitcnt(0);
        unsigned nloc = b.st[0], nx = b.st[1];
        if (nloc == 0u) { xcd_barrier_complete(bar, b.x, nloc, nx); b.st[0] = nloc; b.st[1] = nx; }
        const unsigned old = xb_add(&bar[XB_XSUB(b.x)], 1u);
        const unsigned gen = old / nloc;
        if (old + 1u == (gen + 1u) * nloc) {
            __builtin_amdgcn_fence(__ATOMIC_RELEASE, "agent");
            asm volatile("s_waitcnt vmcnt(0)" ::: "memory");
            const unsigned og = xb_add(&bar[XB_TOP], 1u);
            const unsigned tg = og / nx;
            if (og + 1u == (tg + 1u) * nx) xb_add(&bar[XB_TOPGEN], 1u);
            else XB_SPIN(xb_ld(&bar[XB_TOPGEN]) == tg, bar);
            __builtin_amdgcn_fence(__ATOMIC_ACQUIRE, "agent");
            xb_add(&bar[XB_XGEN(b.x)], 1u);
            asm volatile("s_waitcnt vmcnt(0)" ::: "memory");
        } else {
            XB_SPIN(xb_ld(&bar[XB_XGEN(b.x)]) == gen, bar);
            __builtin_amdgcn_fence(__ATOMIC_ACQUIRE, "agent");
            asm volatile("s_waitcnt vmcnt(0)" ::: "memory");
        }
    }
    __syncthreads();
}

#ifndef GEMM_MASK
#define GEMM_MASK 63
#endif
#define GEMM_CALL1 if ((GEMM_MASK >> 0) & 1)
#define GEMM_CALL2 if ((GEMM_MASK >> 1) & 1)
#define GEMM_CALL3 if ((GEMM_MASK >> 2) & 1)
#define GEMM_CALL4 if ((GEMM_MASK >> 3) & 1)
#define GEMM_CALL5 if ((GEMM_MASK >> 4) & 1)
#define GEMM_CALL6 if ((GEMM_MASK >> 5) & 1)
struct Args { const float* in[18]; float* out; unsigned char* ws; int ph_lo, ph_hi; };
constexpr int N_PHASES = 21;

__global__ void __launch_bounds__(512, 2) fwd_mega(Args args) {
    extern __shared__ __attribute__((aligned(16))) unsigned char lds[];
    cg::grid_group grid = cg::this_grid();
    Ctx C;
#pragma unroll
    for (int i = 0; i < 18; ++i) C.in[i] = args.in[i];
    C.out = args.out; C.ws = args.ws; C.lds = lds; C.G = gridDim.x;
    PG8_LAS unsigned char* ldsg = (PG8_LAS unsigned char*)lds;
    volatile LAS unsigned* bst = (volatile LAS unsigned*)(ldsg + 131072);
    if (threadIdx.x < 64) bst[threadIdx.x] = 0u;
    __syncthreads();
    XcdBarrier xbar = xcd_barrier_post((unsigned*)(args.ws + 4096 * 4), bst);
    bf16_t* Wb = (bf16_t*)(C.ws + WS_W);
    bf16_t* XN = (bf16_t*)(C.ws + WS_XN);
    bf16_t* BIG = (bf16_t*)(C.ws + WS_BIG);
    for (int ph = args.ph_lo; ph < args.ph_hi; ++ph) {
        if (ph == 0) {
#ifndef NO_P0
 p0_prologue(C);
#endif
 }
        else {
            const int l = (ph - 1) / 10, k = (ph - 1) % 10;
            if (k == 0) {
                __syncthreads();
                pg8::Gemm g{XN, Wb + OW_IN + (size_t)l * DIN * 1024, 1024, 1024, 1024};
                pg8::StdSched S{128, 23, C.G, (int)blockIdx.x, (size_t)256 * 1024 * 2, (size_t)256 * 1024 * 2};
                EpiProj E{BIG, C.in[6] + l * 3072};
                GEMM_CALL1 pg8::gemm_phase<EpiProj, pg8::StdSched, true, true>(ldsg, g, S, E);
#if defined(DUP_P1)
                __syncthreads(); pg8::gemm_phase<EpiProj, pg8::StdSched, true, true>(ldsg, g, S, E);
#endif
            } else if (k == 1) {
                __syncthreads();
#ifndef NO_P2
                p2_prep(C, l);
#endif
            } else if (k == 2) {
                __syncthreads();
#ifndef NO_ATT
                p3_attn(C, l, 0);
#if defined(DUP_ATT)
                if (l == 0) { __syncthreads(); p3_attn(C, l, 1); }
#endif
#endif
#ifndef NO_NAT
                p3_natten(C, l, 0);
#if defined(DUP_NAT)
                if (l == 0) p3_natten(C, l, 1);
#endif
#endif
                __syncthreads();
                pg8::Gemm g{(const bf16_t*)(C.ws + WS_XN), Wb + OW_POOL + (size_t)l * 512 * 512, 512, 512, 512};
                pg8::StdSched S{128, 2, C.G, (int)blockIdx.x, (size_t)256 * 512 * 2, (size_t)256 * 512 * 2};
                EpiPlain E{BIG + C_POOL, DIN};
                GEMM_CALL2 pg8::gemm_phase<EpiPlain, pg8::StdSched, true, true>(ldsg, g, S, E);
            } else if (k == 3) {
                __syncthreads();
                pg8::Gemm g{BIG, Wb + OW_BR + (size_t)l * 3 * 1024 * 512, DIN, 512, 512};
                BranchSched S{C.G, (int)blockIdx.x};
                EpiBranch E{BIG, XN};
                GEMM_CALL3 pg8::gemm_phase<EpiBranch, BranchSched, true, true>(ldsg, g, S, E);
            } else if (k == 4) {
                __syncthreads();
                pg8::Gemm g{XN, Wb + OW_OUT + (size_t)l * 1024 * 1024, 1024, 1024, 1024};
                pg8::StdSched S{128, 4, C.G, (int)blockIdx.x, (size_t)256 * 1024 * 2, (size_t)256 * 1024 * 2};
                EpiPlain E{BIG, DM};
                GEMM_CALL4 pg8::gemm_phase<EpiPlain, pg8::StdSched, true, true>(ldsg, g, S, E);
            } else if (k == 5) {
                int tid_ = threadIdx.x; asm volatile("" : "+v"(tid_)); const int lane = tid_ & 63, gw = blockIdx.x * 8 + __builtin_amdgcn_readfirstlane(tid_ >> 6), NGW = C.G * 8;
                const float* xin = (l == 0) ? C.in[0] : C.out;
                for (int m = gw; m < NTOK; m += NGW)
                    resnorm_row(BIG + (size_t)m * DM, xin + (size_t)m * DM, C.in[2] + l * DM, C.out + (size_t)m * DM, C.in[3] + l * DM, XN + (size_t)m * DM, lane);
            } else if (k == 6) {
                __syncthreads();
                pg8::Gemm g{XN, Wb + OW_UP + (size_t)l * DUP * 1024, 1024, 1024, 1024};
                pg8::StdSched S{128, 22, C.G, (int)blockIdx.x, (size_t)256 * 1024 * 2, (size_t)256 * 1024 * 2};
                EpiUp E{BIG, (bf16_t*)(C.ws + WS_VAT)};
                GEMM_CALL5 pg8::gemm_phase<EpiUp, pg8::StdSched, true, true>(ldsg, g, S, E);
            } else if (k == 7) {
#ifndef NO_P8
                p8_convact(C, l);
#endif
            } else if (k == 8) {
                __syncthreads();
                pg8::Gemm g{BIG, Wb + OW_DN + (size_t)l * 1024 * DFF, DUP, DFF, DFF};
                pg8::StdSched S{128, 4, C.G, (int)blockIdx.x, (size_t)256 * DUP * 2, (size_t)256 * DFF * 2};
                EpiPlain E{XN, DM};
                GEMM_CALL6 pg8::gemm_phase<EpiPlain, pg8::StdSched, true, true>(ldsg, g, S, E);
            } else {
                int tid_ = threadIdx.x; asm volatile("" : "+v"(tid_)); const int lane = tid_ & 63, gw = blockIdx.x * 8 + __builtin_amdgcn_readfirstlane(tid_ >> 6), NGW = C.G * 8;
                const float* gnext = (l == 0) ? (C.in[1] + DM) : nullptr;
                for (int m = gw; m < NTOK; m += NGW)
                    resnorm_row(XN + (size_t)m * DM, C.out + (size_t)m * DM, C.in[4] + l * DM, C.out + (size_t)m * DM, gnext, XN + (size_t)m * DM, lane);
            }
        }
        if (ph + 1 < args.ph_hi) { if (ph == 0) grid.sync(); else xcd_barrier(xbar); }
    }
}

#ifndef MK_N_LAUNCHES
#define MK_N_LAUNCHES 1
#endif
extern "C" void kernel_launch(void* const* d_in, const int* in_sizes, int n_in, void* d_out, int out_size, void* d_ws, size_t ws_size, hipStream_t stream) {
    static int grid = 0;
    if (grid == 0) {
        if (n_in != 18 || out_size != NTOK * DM || ws_size < WS_END) { fprintf(stderr, "kernel_launch: unexpected shapes (n_in %d out %d ws %zu)\n", n_in, out_size, ws_size); grid = -1; return; }
        int dev = 0, cus = 0, per_cu = 0;
        hipGetDevice(&dev); hipDeviceGetAttribute(&cus, hipDeviceAttributeMultiprocessorCount, dev);
        if (hipFuncSetAttribute((const void*)fwd_mega, hipFuncAttributeMaxDynamicSharedMemorySize, LDS_BYTES) != hipSuccess) { fprintf(stderr, "kernel_launch: hipFuncSetAttribute failed\n"); grid = -1; return; }
        if (hipOccupancyMaxActiveBlocksPerMultiprocessor(&per_cu, (const void*)fwd_mega, 512, LDS_BYTES) != hipSuccess || per_cu < 1) { fprintf(stderr, "kernel_launch: occupancy query says %d\n", per_cu); per_cu = 1; }
        (void)hipGetLastError();
        grid = cus;
    }
    if (grid < 0) return;
    if (hipMemsetAsync(d_ws, 0, 1 << 20, stream) != hipSuccess) { fprintf(stderr, "kernel_launch: memset failed\n"); return; }
    Args a{};
    for (int i = 0; i < 18; ++i) a.in[i] = (const float*)d_in[i];
    a.out = (float*)d_out; a.ws = (unsigned char*)d_ws;
    if (MK_N_LAUNCHES == 1) {
        a.ph_lo = 0; a.ph_hi = N_PHASES;
        void* kargs[] = {&a};
        hipError_t e = hipLaunchCooperativeKernel((const void*)fwd_mega, dim3(grid), dim3(512), kargs, LDS_BYTES, stream);
        if (e != hipSuccess) fprintf(stderr, "cooperative launch failed: %s (grid %d)\n", hipGetErrorString(e), grid);
    } else {
        for (int ph = 0; ph < N_PHASES; ++ph) { a.ph_lo = ph; a.ph_hi = ph + 1; hipLaunchKernelGGL(fwd_mega, dim3(grid), dim3(512), LDS_BYTES, stream, a); }
    }
}
```

```cpp
#include <hip/hip_runtime.h>
#include <hip/hip_cooperative_groups.h>
#include <cstdio>
#include <cstdint>
namespace cg = cooperative_groups;

#ifndef WGM_BIG
#define WGM_BIG 4
#endif
#ifndef WGM_SMALL
#define WGM_SMALL 2
#endif
__device__ __forceinline__ int lane_now() { int l_; asm volatile("v_mbcnt_lo_u32_b32 %0, -1, 0\n\tv_mbcnt_hi_u32_b32 %0, -1, %0" : "=v"(l_)); return l_; }
#define TID_NOW(wv) (((wv) << 6) | lane_now())
namespace pg8 {
#define PG8_LAS __attribute__((address_space(3)))
typedef unsigned short bf16_t;
typedef short bf16x8 __attribute__((ext_vector_type(8)));
typedef float f32x4 __attribute__((ext_vector_type(4)));
typedef unsigned u32x4 __attribute__((ext_vector_type(4)));
constexpr int BM = 256, BK = 64, HALF = 128, HTB = HALF * BK * 2, STAGE_BYTES = 8 * HTB, NXCD = 8;

__host__ __device__ __forceinline__ int lds_byte(int r, int c) { const int st = (r >> 4) * 2 + (c >> 5), rr = r & 15, cc = c & 31, ob = rr * 64 + cc * 2; return st * 1024 + (ob ^ (((ob >> 9) & 1) << 5)); }
__host__ __device__ __forceinline__ void stage_rc(int b, int& R, int& C) { const int st = b / 1024, sb = b % 1024, swz = sb ^ (((sb >> 9) & 1) << 5); R = (st >> 1) * 16 + swz / 64; C = (st & 1) * 32 + (swz % 64) / 2; }
__host__ __device__ __forceinline__ int perm32(int rho) { const int n = rho >> 4, i = rho & 15; return 8 * (i >> 2) + 4 * n + (i & 3); }

struct Unit { int pm, pn, n; size_t aoff, boff; };
struct Gemm { const bf16_t* A; const bf16_t* Bt; int lda, ldb, K, wv; };

__device__ __forceinline__ void tile_of(int L, int nM, int nN, int WGM, int& pm, int& pn) {
    const int nwg = nM * nN; int wgid = L; { const int q = nwg / NXCD, r = nwg % NXCD, xcd = wgid % NXCD, off = wgid / NXCD; wgid = (xcd < r ? xcd * (q + 1) : r * (q + 1) + (xcd - r) * q) + off; }
    const int nig = WGM * nN, gid = wgid / nig, fm = gid * WGM, gsz = (nM - fm) < WGM ? (nM - fm) : WGM;
    pm = fm + ((wgid % nig) % gsz); pn = (wgid % nig) / gsz;
}
struct StdSched {
    int nM, nN, G, c; size_t astep, bstep; int wgm;
    __device__ __forceinline__ bool next(int i, Unit& u) const {
        const long L = (long)i * G + c; if (L >= (long)nM * nN) return false;
        tile_of((int)L, nM, nN, wgm, u.pm, u.pn); u.n = 0; u.aoff = (size_t)u.pm * astep; u.boff = (size_t)u.pn * bstep; return true;
    }
    __device__ __forceinline__ void a_ready(const Unit&) const {}
    __device__ __forceinline__ void done(const Unit&) const {}
};
__device__ __forceinline__ unsigned cvt_pk_bf16(float lo, float hi) { unsigned r; asm volatile("v_cvt_pk_bf16_f32 %0, %1, %2" : "=v"(r) : "v"(lo), "v"(hi)); return r; }
template <class Epi, class Sched, bool ALIGN_EPI = false, bool SP2 = false>
__device__ __forceinline__ void gemm_phase(PG8_LAS unsigned char* lds, const Gemm g, const Sched& S, const Epi& E) {
    int tid_ = TID_NOW(g.wv); asm volatile("" : "+v"(tid_));
    const int tid = tid_, wid = __builtin_amdgcn_readfirstlane(tid >> 6), lane = tid & 63, wr = wid >> 2, wc = wid & 3, fr = lane & 15, fq = lane >> 4;
    const int K = g.K, nt = K / BK;
    unsigned voffA[2], voffB[2];
#pragma unroll
    for (int i = 0; i < 2; ++i) { int R, C; stage_rc(tid * 16 + i * 8192, R, C); const int Rb = Epi::PERM ? ((R & ~31) + perm32(R & 31)) : R;
        voffA[i] = (unsigned)(R * g.lda + C) * 2u; voffB[i] = (unsigned)(Rb * g.ldb + C) * 2u; }
    const size_t kstep = (size_t)(BK * 2);
    const size_t hstepA = (size_t)HALF * g.lda * 2, hstepB = (size_t)HALF * g.ldb * 2;
    const unsigned ldsw = (unsigned)wid * 1024u;
    const int aoff = lds_byte(wr * 64 + fr, fq * 8), boff = lds_byte(wc * 32 + fr, fq * 8);
#define PG8_SA(b, h) (((b) * 2 + (h)) * HTB)
#define PG8_SB(b, h) ((4 + (b) * 2 + (h)) * HTB)
#define PG8_STAGE(bufoff, gbase, voff) do { _Pragma("unroll") for (int _i = 0; _i < 2; ++_i) \
        __builtin_amdgcn_global_load_lds((const unsigned*)((const char*)(gbase) + (voff)[_i]), (PG8_LAS unsigned*)(lds + (bufoff) + ldsw + _i * 8192), 16, 0, 0); } while (0)
#define PG8_LDA(dst, b, h) do { _Pragma("unroll") for (int m = 0; m < 4; ++m) _Pragma("unroll") for (int k = 0; k < 2; ++k) dst[m][k] = *(const PG8_LAS bf16x8*)(lds + PG8_SA(b, h) + aoff + m * 2048 + k * 1024); } while (0)
#define PG8_LDB(dst, b, h) do { _Pragma("unroll") for (int n = 0; n < 2; ++n) _Pragma("unroll") for (int k = 0; k < 2; ++k) dst[n][k] = *(const PG8_LAS bf16x8*)(lds + PG8_SB(b, h) + boff + n * 2048 + k * 1024); } while (0)
#define PG8_MMA(ai, bj, At, Bt) do { __builtin_amdgcn_s_setprio(1); _Pragma("unroll") for (int m = 0; m < 4; ++m) _Pragma("unroll") for (int n = 0; n < 2; ++n) _Pragma("unroll") for (int k = 0; k < 2; ++k) \
        acc[ai][bj][m][n] = __builtin_amdgcn_mfma_f32_16x16x32_bf16(Bt[n][k], At[m][k], acc[ai][bj][m][n], 0, 0, 0); __builtin_amdgcn_s_setprio(0); } while (0)
#define PG8_WAIT_V(n) asm volatile("s_waitcnt vmcnt(" #n ")" ::: "memory")
#define PG8_WAIT_L(n) asm volatile("s_waitcnt lgkmcnt(" #n ")" ::: "memory")
#define PG8_BAR __builtin_amdgcn_s_barrier()
#define PG8_SCHED __builtin_amdgcn_sched_barrier(0)
    Unit cur, nxt; int ui = 0;
    if (!S.next(0, cur)) return;
    f32x4 acc[2][2][4][2];
#pragma unroll
    for (int a = 0; a < 2; ++a)
#pragma unroll
        for (int b = 0; b < 2; ++b)
#pragma unroll
            for (int m = 0; m < 4; ++m)
#pragma unroll
                for (int n = 0; n < 2; ++n) acc[a][b][m][n] = (f32x4){0.f, 0.f, 0.f, 0.f};
    bf16x8 At[4][2], B0[2][2], B1[2][2];
    const char* cA = (const char*)g.A + cur.aoff; const char* cB = (const char*)g.Bt + cur.boff;
    S.a_ready(cur);
    if constexpr (SP2) {
        PG8_STAGE(PG8_SB(0, 0), cB, voffB); PG8_STAGE(PG8_SB(0, 1), cB + hstepB, voffB); PG8_STAGE(PG8_SA(0, 0), cA, voffA); PG8_STAGE(PG8_SA(0, 1), cA + hstepA, voffA);
        if (wr == 1) PG8_BAR;
        PG8_WAIT_V(2); PG8_BAR;
        PG8_STAGE(PG8_SB(1, 0), cB + kstep, voffB); PG8_STAGE(PG8_SA(1, 0), cA + kstep, voffA); PG8_STAGE(PG8_SB(1, 1), cB + hstepB + kstep, voffB);
        PG8_WAIT_V(6); PG8_BAR;
    } else {
        PG8_STAGE(PG8_SB(0, 0), cB, voffB); PG8_STAGE(PG8_SA(0, 0), cA, voffA); PG8_STAGE(PG8_SB(0, 1), cB + hstepB, voffB); PG8_STAGE(PG8_SA(0, 1), cA + hstepA, voffA);
        if (wr == 1) PG8_BAR;
        PG8_WAIT_V(4); PG8_BAR;
        PG8_STAGE(PG8_SB(1, 0), cB + kstep, voffB); PG8_STAGE(PG8_SA(1, 0), cA + kstep, voffA); PG8_STAGE(PG8_SB(1, 1), cB + hstepB + kstep, voffB);
        PG8_WAIT_V(6); PG8_BAR;
    }
    for (;;) {
        const bool has_next = S.next(ui + 1, nxt);
        const char* nA = has_next ? (const char*)g.A + nxt.aoff : cA; const char* nB = has_next ? (const char*)g.Bt + nxt.boff : cB;
        for (int t = 0; t < nt; t += 2) {
            const bool last = (t == nt - 2);
            const char* a1 = cA + (size_t)(t + 1) * kstep;
            const char* a2 = last ? nA : cA + (size_t)(t + 2) * kstep; const char* b2 = last ? nB : cB + (size_t)(t + 2) * kstep;
            const char* a3 = a2 + kstep; const char* b3 = b2 + kstep;
            if (last && has_next) S.a_ready(nxt);
            if constexpr (SP2) {
            PG8_LDB(B0, 0, 0); PG8_LDB(B1, 0, 1); PG8_SCHED; PG8_LDA(At, 0, 0); PG8_STAGE(PG8_SA(1, 1), a1 + hstepA, voffA);
            PG8_WAIT_V(8); PG8_WAIT_L(0); PG8_BAR; PG8_MMA(0, 0, At, B0); PG8_MMA(0, 1, At, B1); PG8_BAR; PG8_SCHED;
            PG8_LDA(At, 0, 1); PG8_STAGE(PG8_SB(0, 0), b2, voffB); PG8_STAGE(PG8_SB(0, 1), b2 + hstepB, voffB); PG8_STAGE(PG8_SA(0, 0), a2, voffA);
            PG8_WAIT_V(8); PG8_WAIT_L(0); PG8_BAR; PG8_MMA(1, 0, At, B0); PG8_MMA(1, 1, At, B1); PG8_BAR; PG8_SCHED;
            PG8_LDB(B0, 1, 0); PG8_LDB(B1, 1, 1); PG8_SCHED; PG8_LDA(At, 1, 0); PG8_STAGE(PG8_SA(0, 1), a2 + hstepA, voffA);
            PG8_WAIT_V(8); PG8_WAIT_L(0); PG8_BAR; PG8_MMA(0, 0, At, B0); PG8_MMA(0, 1, At, B1); PG8_BAR; PG8_SCHED;
            PG8_LDA(At, 1, 1); PG8_STAGE(PG8_SB(1, 0), b3, voffB); PG8_STAGE(PG8_SB(1, 1), b3 + hstepB, voffB); PG8_STAGE(PG8_SA(1, 0), a3, voffA);
            PG8_WAIT_V(8); PG8_WAIT_L(0); PG8_BAR; PG8_MMA(1, 0, At, B0); PG8_MMA(1, 1, At, B1); PG8_BAR; PG8_SCHED;
            } else {
            PG8_LDB(B0, 0, 0); PG8_SCHED; PG8_LDA(At, 0, 0); PG8_STAGE(PG8_SA(1, 1), a1 + hstepA, voffA);
            PG8_WAIT_L(8); PG8_BAR; PG8_WAIT_L(0); PG8_MMA(0, 0, At, B0); PG8_BAR; PG8_SCHED;
            PG8_LDB(B1, 0, 1); PG8_STAGE(PG8_SB(0, 0), b2, voffB);
            PG8_BAR; PG8_WAIT_L(0); PG8_MMA(0, 1, At, B1); PG8_BAR;
            PG8_LDA(At, 0, 1); PG8_STAGE(PG8_SA(0, 0), a2, voffA);
            PG8_BAR; PG8_WAIT_L(0); PG8_MMA(1, 0, At, B0); PG8_BAR; PG8_SCHED;
            PG8_STAGE(PG8_SB(0, 1), b2 + hstepB, voffB);
            PG8_WAIT_V(6); PG8_BAR; PG8_MMA(1, 1, At, B1); PG8_BAR;
            PG8_LDB(B0, 1, 0); PG8_SCHED; PG8_LDA(At, 1, 0); PG8_STAGE(PG8_SA(0, 1), a2 + hstepA, voffA);
            PG8_WAIT_L(8); PG8_BAR; PG8_WAIT_L(0); PG8_MMA(0, 0, At, B0); PG8_BAR; PG8_SCHED;
            PG8_LDB(B1, 1, 1); PG8_STAGE(PG8_SB(1, 0), b3, voffB);
            PG8_BAR; PG8_WAIT_L(0); PG8_MMA(0, 1, At, B1); PG8_BAR;
            PG8_LDA(At, 1, 1); PG8_STAGE(PG8_SA(1, 0), a3, voffA);
            PG8_BAR; PG8_WAIT_L(0); PG8_MMA(1, 0, At, B0); PG8_BAR; PG8_SCHED;
            PG8_STAGE(PG8_SB(1, 1), b3 + hstepB, voffB);
            PG8_WAIT_V(6); PG8_BAR; PG8_MMA(1, 1, At, B1); PG8_BAR;
            }
        }
        if constexpr (ALIGN_EPI) { if (wr == 0) PG8_BAR; }
        bool fin_ = true;
        if constexpr (Epi::KEEP) { fin_ = E.run(acc, cur, wr, wc, fr, fq); } else if constexpr (!Epi::AFTER_DRAIN) { E(acc, cur, wr, wc, fr, fq); S.done(cur); }
        if (!has_next) break;
        if (fin_) {
#pragma unroll
        for (int a = 0; a < 2; ++a)
#pragma unroll
            for (int b = 0; b < 2; ++b)
#pragma unroll
                for (int m = 0; m < 4; ++m)
#pragma unroll
                    for (int n = 0; n < 2; ++n) acc[a][b][m][n] = (f32x4){0.f, 0.f, 0.f, 0.f};
        }
        cur = nxt; cA = nA; cB = nB; ++ui;
        if constexpr (ALIGN_EPI) { if (wr == 1) PG8_BAR; }
    }
    PG8_WAIT_V(0);
    if constexpr (!ALIGN_EPI) { if (wr == 0) PG8_BAR; }
    PG8_BAR;
    if constexpr (Epi::AFTER_DRAIN) { E.fused(acc, cur, wr, wc, fr, fq, lds, wid, lane); S.done(cur); }
#undef PG8_SA
#undef PG8_SB
#undef PG8_STAGE
#undef PG8_LDA
#undef PG8_LDB
#undef PG8_MMA
#undef PG8_WAIT_V
#undef PG8_WAIT_L
#undef PG8_BAR
#undef PG8_SCHED
}
}

typedef unsigned short bf16_t;
typedef short bf16x8 __attribute__((ext_vector_type(8)));
typedef float f32x4 __attribute__((ext_vector_type(4)));
typedef float f32x16 __attribute__((ext_vector_type(16)));
typedef unsigned u32x4 __attribute__((ext_vector_type(4)));
typedef unsigned u32x2 __attribute__((ext_vector_type(2)));
#define LAS __attribute__((address_space(3)))

constexpr int NTOK = 32768, DM = 1024, SEQ = 2048, DIN = 5888, DFF = 2816, DUP = 5632;
constexpr int C_KA = 512, C_VA = 640, C_POOL = 768, C_QC = 1280, C_KC = 1792, C_VC = 2304, C_GATE = 2816;
constexpr float EPS = 1e-6f, LOG2E = 1.4426950408889634f;
constexpr size_t MiB = (size_t)1 << 20;
constexpr size_t WS_W = 1 * MiB;
constexpr size_t WS_XN = 68 * MiB;
constexpr size_t WS_BIG = 132 * MiB;
constexpr size_t WS_VAT = 500 * MiB;
constexpr size_t WS_END = 511 * MiB;
constexpr size_t OW_IN = 0, OW_BR = 12058624, OW_OUT = 15204352, OW_UP = 17301504, OW_DN = 28835840, OW_POOL = 34603008;
constexpr int LDS_BYTES = 131072 + 1024 + 8 * 2304;

__device__ __forceinline__ float bf2f(unsigned v) { return __uint_as_float(v << 16); }
__device__ __forceinline__ float bflo(unsigned u) { return __uint_as_float(u << 16); }
__device__ __forceinline__ float bfhi(unsigned u) { return __uint_as_float(u & 0xffff0000u); }
__device__ __forceinline__ unsigned pk2(float lo, float hi) { return pg8::cvt_pk_bf16(lo, hi); }
__device__ __forceinline__ void unpack8(const u32x4 v, float* f);
__device__ __forceinline__ float wave_sum(float v) {
#pragma unroll
    for (int o = 1; o < 64; o <<= 1) v += __shfl_xor(v, o);
    return v;
}
__device__ __forceinline__ float wave_max(float v) {
#pragma unroll
    for (int o = 1; o < 64; o <<= 1) v = fmaxf(v, __shfl_xor(v, o));
    return v;
}

template <bool NT = false>
__device__ __forceinline__ void stage_store2(bf16_t* tw, int fr, int fq, int lane, const u32x4 w0, const u32x4 w1, bf16_t* g0) {
    *(u32x4*)(tw + fr * 72 + fq * 8) = w0; *(u32x4*)(tw + fr * 72 + 32 + fq * 8) = w1;
    const u32x4 r0 = *(const u32x4*)(tw + (lane >> 2) * 72 + (lane & 3) * 8);
    const u32x4 r1 = *(const u32x4*)(tw + (lane >> 2) * 72 + 32 + (lane & 3) * 8);
    if (NT) { __builtin_nontemporal_store(r0, (u32x4*)g0); __builtin_nontemporal_store(r1, (u32x4*)(g0 + 128)); }
    else { *(u32x4*)g0 = r0; *(u32x4*)(g0 + 128) = r1; }
}
__device__ __forceinline__ void stage_load2(bf16_t* tw, int fr, int fq, int lane, const bf16_t* g0, u32x4& w0, u32x4& w1) {
    const u32x4 r0 = __builtin_nontemporal_load((const u32x4*)g0), r1 = __builtin_nontemporal_load((const u32x4*)(g0 + 128));
    *(u32x4*)(tw + (lane >> 2) * 72 + (lane & 3) * 8) = r0; *(u32x4*)(tw + (lane >> 2) * 72 + 32 + (lane & 3) * 8) = r1;
    w0 = *(const u32x4*)(tw + fr * 72 + fq * 8); w1 = *(const u32x4*)(tw + fr * 72 + 32 + fq * 8);
}
constexpr int EPI_LDS_OFF = 131072 + 1024, EPI_LDS_WAVE = 2304;

struct EpiPlain {
    static constexpr bool PERM = true, AFTER_DRAIN = false, KEEP = false;
    bf16_t* O; int ldc; unsigned char* elds;
    __device__ __forceinline__ void operator()(const f32x4 (&acc)[2][2][4][2], const pg8::Unit& u, int wr, int wc, int fr, int fq) const {
        const int lane = fq * 16 + fr;
        bf16_t* tw = (bf16_t*)(elds + EPI_LDS_OFF + (wr * 4 + wc) * EPI_LDS_WAVE);
        bf16_t* gq = O + (size_t)(u.pm * 256 + wr * 64 + (lane >> 2)) * ldc + u.pn * 256 + wc * 32 + (lane & 3) * 8;
#pragma unroll
        for (int ai = 0; ai < 2; ++ai)
#pragma unroll
            for (int m = 0; m < 4; ++m) { u32x4 w[2];
#pragma unroll
                for (int bj = 0; bj < 2; ++bj) { const f32x4 v0 = acc[ai][bj][m][0], v1 = acc[ai][bj][m][1];
                    w[bj].x = pk2(v0[0], v0[1]); w[bj].y = pk2(v0[2], v0[3]); w[bj].z = pk2(v1[0], v1[1]); w[bj].w = pk2(v1[2], v1[3]); }
                stage_store2(tw, fr, fq, lane, w[0], w[1], gq + (size_t)(ai * 128 + m * 16) * ldc); }
    }
};
struct EpiProj {
    static constexpr bool PERM = true, AFTER_DRAIN = false, KEEP = false;
    bf16_t* O; const float* bgate; unsigned char* elds;
    __device__ __forceinline__ void operator()(const f32x4 (&acc)[2][2][4][2], const pg8::Unit& u, int wr, int wc, int fr, int fq) const {
        const int col0 = u.pn * 256 + wc * 32 + 8 * fq, lane = fq * 16 + fr;
        bf16_t* tw = (bf16_t*)(elds + EPI_LDS_OFF + (wr * 4 + wc) * EPI_LDS_WAVE);
        bf16_t* gq = O + (size_t)(u.pm * 256 + wr * 64 + (lane >> 2)) * DIN + u.pn * 256 + wc * 32 + (lane & 3) * 8;
        const bool gate = (u.pn >= 11);
        f32x4 bv[2][2];
#pragma unroll
        for (int bj = 0; bj < 2; ++bj)
#pragma unroll
            for (int n = 0; n < 2; ++n) bv[bj][n] = gate ? *(const f32x4*)(bgate + (col0 - C_GATE) + bj * 128 + 4 * n) : (f32x4){0.f, 0.f, 0.f, 0.f};
#pragma unroll
        for (int ai = 0; ai < 2; ++ai)
#pragma unroll
            for (int m = 0; m < 4; ++m) { u32x4 w[2];
#pragma unroll
                for (int bj = 0; bj < 2; ++bj) { f32x4 v0 = acc[ai][bj][m][0], v1 = acc[ai][bj][m][1];
                    if (gate) {
#pragma unroll
                        for (int j = 0; j < 4; ++j) { v0[j] = __builtin_amdgcn_rcpf(1.f + __expf(-(v0[j] + bv[bj][0][j]))); v1[j] = __builtin_amdgcn_rcpf(1.f + __expf(-(v1[j] + bv[bj][1][j]))); }
                    }
                    w[bj].x = pk2(v0[0], v0[1]); w[bj].y = pk2(v0[2], v0[3]); w[bj].z = pk2(v1[0], v1[1]); w[bj].w = pk2(v1[2], v1[3]); }
                if (gate) stage_store2<true>(tw, fr, fq, lane, w[0], w[1], gq + (size_t)(ai * 128 + m * 16) * DIN);
                else stage_store2<false>(tw, fr, fq, lane, w[0], w[1], gq + (size_t)(ai * 128 + m * 16) * DIN); }
    }
};
struct EpiBranch {
    static constexpr bool PERM = true, AFTER_DRAIN = false, KEEP = true;
    const bf16_t* P; bf16_t* MG; unsigned char* elds;
    __device__ __forceinline__ bool run(f32x4 (&acc)[2][2][4][2], const pg8::Unit& u, int wr, int wc, int fr, int fq) const {
        const int lane = fq * 16 + fr;
        bf16_t* tw = (bf16_t*)(elds + EPI_LDS_OFF + (wr * 4 + wc) * EPI_LDS_WAVE);
        const size_t rq = (size_t)(u.pm * 256 + wr * 64 + (lane >> 2)); const int cq = u.pn * 256 + wc * 32 + (lane & 3) * 8;
        const bf16_t* gq = P + rq * DIN + C_GATE + u.n * 1024 + cq;
        bf16_t* mq = MG + rq * DM + cq;
#pragma unroll
        for (int ai = 0; ai < 2; ++ai)
#pragma unroll
            for (int m = 0; m < 4; ++m) { const size_t ro = (size_t)(ai * 128 + m * 16);
                u32x4 gt[2], gn[2];
                stage_load2(tw, fr, fq, lane, gq + ro * DIN, gt[0], gt[1]);
                if (u.n < 2) stage_load2(tw, fr, fq, lane, gq + ro * DIN + 1024, gn[0], gn[1]);
                u32x4 w[2];
#pragma unroll
                for (int bj = 0; bj < 2; ++bj) {
                    float g[8]; g[0] = bflo(gt[bj].x); g[1] = bfhi(gt[bj].x); g[2] = bflo(gt[bj].y); g[3] = bfhi(gt[bj].y); g[4] = bflo(gt[bj].z); g[5] = bfhi(gt[bj].z); g[6] = bflo(gt[bj].w); g[7] = bfhi(gt[bj].w);
                    if (u.n > 0) {
#pragma unroll
                        for (int e = 0; e < 8; ++e) g[e] = fmaxf(g[e], 1e-6f);
                    }
                    if (u.n < 2) {
                        float h[8]; h[0] = bflo(gn[bj].x); h[1] = bfhi(gn[bj].x); h[2] = bflo(gn[bj].y); h[3] = bfhi(gn[bj].y); h[4] = bflo(gn[bj].z); h[5] = bfhi(gn[bj].z); h[6] = bflo(gn[bj].w); h[7] = bfhi(gn[bj].w);
#pragma unroll
                        for (int e = 0; e < 8; ++e) g[e] = g[e] * __builtin_amdgcn_rcpf(fmaxf(h[e], 1e-6f));
                    }
                    f32x4 a0 = acc[ai][bj][m][0], a1 = acc[ai][bj][m][1];
                    a0[0] *= g[0]; a0[1] *= g[1]; a0[2] *= g[2]; a0[3] *= g[3]; a1[0] *= g[4]; a1[1] *= g[5]; a1[2] *= g[6]; a1[3] *= g[7];
                    if (u.n < 2) { acc[ai][bj][m][0] = a0; acc[ai][bj][m][1] = a1; }
                    else { w[bj].x = pk2(a0[0], a0[1]); w[bj].y = pk2(a0[2], a0[3]); w[bj].z = pk2(a1[0], a1[1]); w[bj].w = pk2(a1[2], a1[3]); } }
                if (u.n == 2) stage_store2(tw, fr, fq, lane, w[0], w[1], mq + ro * DM); }
        return u.n == 2;
    }
};
struct BranchSched {
    int G, c;
    __device__ __forceinline__ bool next(int i, pg8::Unit& u) const {
        const int t = i / 3, n = i - 3 * t; const long L = (long)t * G + c; if (L >= 512) return false;
        pg8::tile_of((int)L, 128, 4, WGM_SMALL, u.pm, u.pn); u.n = n;
        const int colA = (n == 0) ? 0 : (n == 1 ? C_POOL : C_QC);
        u.aoff = ((size_t)u.pm * 256 * DIN + colA) * 2; u.boff = ((size_t)(n * 1024 + u.pn * 256) * 512) * 2; return true;
    }
    __device__ __forceinline__ void a_ready(const pg8::Unit&) const {}
    __device__ __forceinline__ void done(const pg8::Unit&) const {}
};
struct EpiUp {
    static constexpr bool PERM = true, AFTER_DRAIN = false, KEEP = false;
    bf16_t* O; bf16_t* HALO; unsigned char* elds;
    __device__ __forceinline__ void operator()(const f32x4 (&acc)[2][2][4][2], const pg8::Unit& u, int wr, int wc, int fr, int fq) const {
        const int col0 = u.pn * 256 + wc * 32 + 8 * fq, lane = fq * 16 + fr;
        bf16_t* tw = (bf16_t*)(elds + EPI_LDS_OFF + (wr * 4 + wc) * EPI_LDS_WAVE);
        bf16_t* gq = O + (size_t)(u.pm * 256 + wr * 64 + (lane >> 2)) * DUP + u.pn * 256 + wc * 32 + (lane & 3) * 8;
        const bool val = (u.pn < 11);
#pragma unroll
        for (int ai = 0; ai < 2; ++ai)
#pragma unroll
            for (int m = 0; m < 4; ++m) { u32x4 ww[2];
#pragma unroll
                for (int bj = 0; bj < 2; ++bj) { const f32x4 v0 = acc[ai][bj][m][0], v1 = acc[ai][bj][m][1];
                    u32x4 w; w.x = pk2(v0[0], v0[1]); w.y = pk2(v0[2], v0[3]); w.z = pk2(v1[0], v1[1]); w.w = pk2(v1[2], v1[3]);
                    ww[bj] = w;
                    if (val && (m & 1) == 0 && fr == 0)  *(u32x4*)(HALO + ((size_t)((u.pm * 8 + ai * 4 + wr * 2 + (m >> 1)) * 2 + 0)) * DFF + col0 + bj * 128) = w;
                    if (val && (m & 1) == 1 && fr == 15) *(u32x4*)(HALO + ((size_t)((u.pm * 8 + ai * 4 + wr * 2 + (m >> 1)) * 2 + 1)) * DFF + col0 + bj * 128) = w; }
                stage_store2(tw, fr, fq, lane, ww[0], ww[1], gq + (size_t)(ai * 128 + m * 16) * DUP); }
    }
};

struct Ctx {
    const float* in[18]; float* out; unsigned char* ws; unsigned char* lds; int G, wv;
};

__device__ __forceinline__ void transpose_item(const float* W, int K, int N, bf16_t* WT, float* scr, int item, int lane) {
    const int nblk = N / 32, kb = item / nblk, nb = item % nblk, k0 = 64 * kb, n0 = 32 * nb;
#pragma unroll 8
    for (int i = 0; i < 32; ++i) { const int kk = 2 * i + (lane >> 5); scr[kk * 33 + (lane & 31)] = __builtin_nontemporal_load(&W[(size_t)(k0 + kk) * N + n0 + (lane & 31)]); }
    asm volatile("s_waitcnt lgkmcnt(0)" ::: "memory");
    const int c = lane & 7;
#pragma unroll
    for (int j = 0; j < 4; ++j) { const int n = (lane >> 3) + 8 * j; const float* s = scr + (8 * c) * 33 + n;
        u32x4 o; o.x = pk2(s[0 * 33], s[1 * 33]); o.y = pk2(s[2 * 33], s[3 * 33]); o.z = pk2(s[4 * 33], s[5 * 33]); o.w = pk2(s[6 * 33], s[7 * 33]);
        *(u32x4*)(WT + (size_t)(n0 + n) * K + k0 + 8 * c) = o; }
    asm volatile("s_waitcnt lgkmcnt(0)" ::: "memory");
}
__device__ __forceinline__ void norm_row(const float* xrow, const float* g, bf16_t* orow, int lane) {
    const f32x4* xr = (const f32x4*)xrow + lane; const f32x4* gr = (const f32x4*)g + lane;
    f32x4 v[4]; float s = 0.f;
#pragma unroll
    for (int j = 0; j < 4; ++j) { v[j] = __builtin_nontemporal_load(&xr[64 * j]); s += (v[j].x * v[j].x + v[j].y * v[j].y) + (v[j].z * v[j].z + v[j].w * v[j].w); }
    const float rs = rsqrtf(wave_sum(s) * (1.f / DM) + EPS);
    u32x2* o8 = (u32x2*)orow + lane;
#pragma unroll
    for (int j = 0; j < 4; ++j) { const f32x4 gg = gr[64 * j]; u32x2 w; w.x = pk2(v[j].x * rs * gg.x, v[j].y * rs * gg.y); w.y = pk2(v[j].z * rs * gg.z, v[j].w * rs * gg.w); o8[64 * j] = w; }
}
template <int R>
__device__ __forceinline__ void resnorm_rows(const bf16_t* src, const float* xin, const float* gpost, float* xo, const float* gnext, bf16_t* xn, size_t rstride, int lane) {
    f32x4 v[R][4], xx[R][4]; float s[R];
#pragma unroll
    for (int r = 0; r < R; ++r) { const u32x2* sr = (const u32x2*)(src + r * rstride) + lane; const f32x4* xr = (const f32x4*)(xin + r * rstride) + lane; s[r] = 0.f;
#pragma unroll
        for (int j = 0; j < 4; ++j) { const u32x2 w = __builtin_nontemporal_load(&sr[64 * j]); xx[r][j] = __builtin_nontemporal_load(&xr[64 * j]); v[r][j] = (f32x4){bflo(w.x), bfhi(w.x), bflo(w.y), bfhi(w.y)}; } }
#pragma unroll
    for (int r = 0; r < R; ++r)
#pragma unroll
        for (int j = 0; j < 4; ++j) s[r] += (v[r][j].x * v[r][j].x + v[r][j].y * v[r][j].y) + (v[r][j].z * v[r][j].z + v[r][j].w * v[r][j].w);
    const f32x4* gp = (const f32x4*)gpost + lane;
    float s2[R];
#pragma unroll
    for (int r = 0; r < R; ++r) { const float rs = rsqrtf(wave_sum(s[r]) * (1.f / DM) + EPS); s2[r] = 0.f; f32x4* xw = (f32x4*)(xo + r * rstride) + lane;
#pragma unroll
        for (int j = 0; j < 4; ++j) { const f32x4 gg = gp[64 * j]; v[r][j] = xx[r][j] + v[r][j] * rs * gg; s2[r] += (v[r][j].x * v[r][j].x + v[r][j].y * v[r][j].y) + (v[r][j].z * v[r][j].z + v[r][j].w * v[r][j].w); __builtin_nontemporal_store(v[r][j], &xw[64 * j]); } }
    if (gnext) {
        const f32x4* gn = (const f32x4*)gnext + lane;
#pragma unroll
        for (int r = 0; r < R; ++r) { const float rs2 = rsqrtf(wave_sum(s2[r]) * (1.f / DM) + EPS); u32x2* o8 = (u32x2*)(xn + r * rstride) + lane;
#pragma unroll
            for (int j = 0; j < 4; ++j) { const f32x4 gg = gn[64 * j]; u32x2 w; w.x = pk2(v[r][j].x * rs2 * gg.x, v[r][j].y * rs2 * gg.y); w.y = pk2(v[r][j].z * rs2 * gg.z, v[r][j].w * rs2 * gg.w); o8[64 * j] = w; } }
    }
}
__device__ __forceinline__ void p0_prologue(const Ctx& C) {
    int tid_ = TID_NOW(C.wv); asm volatile("" : "+v"(tid_)); const int tid = tid_, lane = tid & 63, wave = __builtin_amdgcn_readfirstlane(tid >> 6); (void)tid; (void)lane; (void)wave;
    bf16_t* Wb = (bf16_t*)(C.ws + WS_W);
    float* scr = (float*)(C.lds + wave * 16384);
    const int gw = blockIdx.x * 8 + wave, NGW = C.G * 8;
    constexpr int I_IN = 16 * 184, I_BR = 8 * 32, I_OUT = 16 * 32, I_UP = 16 * 176, I_DN = 44 * 32, I_L = I_IN + 3 * I_BR + I_OUT + I_UP + I_DN;
    for (int it = gw; it < 2 * I_L; it += NGW) {
        const int l = it / I_L; int r = it - l * I_L;
        if (r < I_IN) { transpose_item(C.in[5] + (size_t)l * 1024 * DIN, 1024, DIN, Wb + OW_IN + (size_t)l * DIN * 1024, scr, r, lane); continue; } r -= I_IN;
        if (r < 3 * I_BR) { const int n = r / I_BR; transpose_item(C.in[12] + (size_t)(l * 3 + n) * 512 * 1024, 512, 1024, Wb + OW_BR + (size_t)(l * 3 + n) * 1024 * 512, scr, r - n * I_BR, lane); continue; } r -= 3 * I_BR;
        if (r < I_OUT) { transpose_item(C.in[13] + (size_t)l * 1024 * 1024, 1024, 1024, Wb + OW_OUT + (size_t)l * 1024 * 1024, scr, r, lane); continue; } r -= I_OUT;
        if (r < I_UP) { transpose_item(C.in[14] + (size_t)l * 1024 * DUP, 1024, DUP, Wb + OW_UP + (size_t)l * DUP * 1024, scr, r, lane); continue; } r -= I_UP;
        transpose_item(C.in[17] + (size_t)l * DFF * 1024, DFF, 1024, Wb + OW_DN + (size_t)l * 1024 * DFF, scr, r, lane);
    }
    for (int idx = blockIdx.x * 512 + tid; idx < 2 * 512 * 512; idx += C.G * 512) {
        const int l = idx >> 18, n = (idx >> 9) & 511, k = idx & 511, g = n >> 7;
        float v = 0.f;
        if ((k >> 7) == g) v = C.in[9][((size_t)(l * 4 + g) * 128 + (k & 127)) * 128 + (n & 127)] * C.in[10][l * 512 + n];
        Wb[OW_POOL + idx] = (bf16_t)(pk2(v, 0.f) & 0xffffu);
    }
    bf16_t* XN = (bf16_t*)(C.ws + WS_XN);
    for (int m = gw; m < NTOK; m += NGW) norm_row(C.in[0] + (size_t)m * DM, C.in[1], XN + (size_t)m * DM, lane);
}

__device__ __forceinline__ void p2_prep(const Ctx& C, int l) {
    bf16_t* P = (bf16_t*)(C.ws + WS_BIG);
    bf16_t* DIFF = (bf16_t*)(C.ws + WS_XN);
    bf16_t* VCT = (bf16_t*)(C.ws + WS_XN + 32 * MiB);
    bf16_t* VAT = (bf16_t*)(C.ws + WS_VAT);
    const float* gk = C.in[8] + l * 64;
    int tid_ = TID_NOW(C.wv); asm volatile("" : "+v"(tid_)); const int tid = tid_, lane = tid & 63, wave = __builtin_amdgcn_readfirstlane(tid >> 6); (void)tid;
    bf16_t* TA = (bf16_t*)(C.lds + wave * 10752);
    bf16_t* TC = TA + 8 * 136;
    int bx = blockIdx.x; asm volatile("" : "+s"(bx));
    const int gw = bx * 8 + wave, NGW = C.G * 8;
    const int g = lane >> 4, hw = 1 << g;
    const u32x4 zero4 = {0u, 0u, 0u, 0u};
    for (int cq = gw; cq < NTOK / 8; cq += NGW) {
        const int ck = cq;
        const int tok0 = ck * 8, b = tok0 >> 11, s0 = tok0 & 2047, r = s0 >> 6, c8 = (s0 >> 3) & 7;
        {
            const int j16 = lane & 15, rg = lane >> 4;
            u32x2 raw[4];
#pragma unroll
            for (int ps = 0; ps < 4; ++ps) { const int rw = ps * 4 + rg, tok = tok0 + (rw >> 1); raw[ps] = *(const u32x2*)(P + (size_t)tok * DIN + C_KA + (rw & 1) * 64 + 4 * j16); }
            const f32x4 gk4 = *(const f32x4*)(gk + 4 * j16);
            const bool hi16 = (j16 & 4) != 0;
#pragma unroll
            for (int ps = 0; ps < 4; ++ps) {
                const int rw = ps * 4 + rg, tok = tok0 + (rw >> 1), t = tok & 2047;
                float x[4] = {bflo(raw[ps].x), bfhi(raw[ps].x), bflo(raw[ps].y), bfhi(raw[ps].y)};
                float ss = x[0] * x[0] + x[1] * x[1] + x[2] * x[2] + x[3] * x[3];
                ss += __shfl_xor(ss, 1); ss += __shfl_xor(ss, 2); ss += __shfl_xor(ss, 4); ss += __shfl_xor(ss, 8);
                const float rs = rsqrtf(ss * (1.f / 64.f) + EPS);
                const float pos = (float)((j16 < 8) ? (t >> 6) : (t & 63));
                float o[4];
#pragma unroll
                for (int e = 0; e < 4; ++e) {
                    const int fi = (4 * j16 + e) & 15;
                    const float ang = pos * __builtin_amdgcn_exp2f(-13.287712379549449f * (float)fi * (1.f / 16.f));
                    const float y = x[e] * rs * gk4[e];
                    const float prt = __shfl_xor(y, 4);
                    o[e] = y * __cosf(ang) + (hi16 ? prt : -prt) * __sinf(ang);
                }
                u32x2 ov; ov.x = pk2(o[0], o[1]); ov.y = pk2(o[2], o[3]);
                *(u32x2*)(P + (size_t)tok * DIN + C_KA + (rw & 1) * 64 + 4 * j16) = ov;
            }
        }
        u32x4 vc[8], va[2], pr[23];
#pragma unroll
        for (int k = 0; k < 8; ++k) vc[k] = *(const u32x4*)(P + (size_t)(tok0 + k) * DIN + C_VC + 8 * lane);
#pragma unroll
        for (int j = 0; j < 2; ++j) va[j] = *(const u32x4*)(P + (size_t)(tok0 + 4 * j + (lane >> 4)) * DIN + C_VA + 8 * (lane & 15));
        const bf16_t* pbase = P + (size_t)(b * SEQ) * DIN + C_POOL + 8 * lane;
#pragma unroll
        for (int o = 0; o < 23; ++o) { const int row = s0 + o - 8; const bool need = (o - 8 >= -hw) && (o - 8 < 8 + hw) && row >= 0 && row < SEQ;
            pr[o] = zero4; if (need) pr[o] = *(const u32x4*)(pbase + (size_t)row * DIN); }
#pragma unroll
        for (int k = 0; k < 8; ++k) *(u32x4*)(TC + k * 520 + 8 * lane) = vc[k];
#pragma unroll
        for (int j = 0; j < 2; ++j) *(u32x4*)(TA + (4 * j + (lane >> 4)) * 136 + 8 * (lane & 15)) = va[j];
#pragma unroll
        for (int k = 0; k < 8; ++k) {
            float w2[8], w4[8], w8[8], w16[8];
#define ACC_ROW(dst, idx) do { float f_[8]; u32x4 t_ = pr[idx]; asm volatile("" : "+v"(t_));     unpack8(t_, f_); _Pragma("unroll") for (int e = 0; e < 8; ++e) dst[e] += f_[e]; } while (0)
#pragma unroll
            for (int e = 0; e < 8; ++e) w2[e] = 0.f;
            ACC_ROW(w2, k + 7); ACC_ROW(w2, k + 8);
#pragma unroll
            for (int e = 0; e < 8; ++e) w4[e] = w2[e];
            ACC_ROW(w4, k + 6); ACC_ROW(w4, k + 9);
#pragma unroll
            for (int e = 0; e < 8; ++e) w8[e] = w4[e];
            ACC_ROW(w8, k + 4); ACC_ROW(w8, k + 5); ACC_ROW(w8, k + 10); ACC_ROW(w8, k + 11);
#pragma unroll
            for (int e = 0; e < 8; ++e) w16[e] = w8[e];
            ACC_ROW(w16, k + 0); ACC_ROW(w16, k + 1); ACC_ROW(w16, k + 2); ACC_ROW(w16, k + 3); ACC_ROW(w16, k + 12); ACC_ROW(w16, k + 13); ACC_ROW(w16, k + 14); ACC_ROW(w16, k + 15);
#undef ACC_ROW
            const int t = s0 + k; int lo = t - hw; if (lo < 0) lo = 0; int hi = t + hw; if (hi > SEQ) hi = SEQ;
            const float inv = 1.f / (float)(hi - lo);
            float self[8]; unpack8(pr[k + 8], self);
            float o[8];
#pragma unroll
            for (int e = 0; e < 8; ++e) { const float sm = (g == 0) ? w2[e] : (g == 1) ? w4[e] : (g == 2) ? w8[e] : w16[e]; o[e] = sm * inv - self[e]; }
            u32x4 ov; ov.x = pk2(o[0], o[1]); ov.y = pk2(o[2], o[3]); ov.z = pk2(o[4], o[5]); ov.w = pk2(o[6], o[7]);
            *(u32x4*)(DIFF + (size_t)(tok0 + k) * 512 + 8 * lane) = ov;
        }
#pragma unroll
        for (int kk = 0; kk < 2; ++kk) { const int rw = lane + 64 * kk; unsigned pkd[4];
#pragma unroll
            for (int k = 0; k < 4; ++k) pkd[k] = (unsigned)TA[(2 * k) * 136 + rw] | ((unsigned)TA[(2 * k + 1) * 136 + rw] << 16);
            *(u32x4*)(VAT + ((size_t)(b * 128 + rw)) * SEQ + s0) = (u32x4){pkd[0], pkd[1], pkd[2], pkd[3]}; }
#pragma unroll
        for (int kk = 0; kk < 8; ++kk) { const int cc = lane + 64 * kk; unsigned pkd[4];
#pragma unroll
            for (int k = 0; k < 4; ++k) pkd[k] = (unsigned)TC[(2 * k) * 520 + cc] | ((unsigned)TC[(2 * k + 1) * 520 + cc] << 16);
            *(u32x4*)(VCT + ((size_t)((((b * 8 + kk) * 32 + r) * 8 + c8) * 64 + lane)) * 8) = (u32x4){pkd[0], pkd[1], pkd[2], pkd[3]}; }
    }
}

__device__ __forceinline__ void attn_qprep(const Ctx& C, int l, const bf16_t* Qrow, int tq, int hi_in, bf16_t* qdst) {
    int hi = hi_in; asm volatile("" : "+v"(hi));
    float xq[4][8]; float ss = 0.f;
#pragma unroll
    for (int ks = 0; ks < 4; ++ks) { const u32x4 rq = __builtin_nontemporal_load((const u32x4*)(Qrow + 16 * ks + 8 * hi));
        xq[ks][0] = bflo(rq.x); xq[ks][1] = bfhi(rq.x); xq[ks][2] = bflo(rq.y); xq[ks][3] = bfhi(rq.y); xq[ks][4] = bflo(rq.z); xq[ks][5] = bfhi(rq.z); xq[ks][6] = bflo(rq.w); xq[ks][7] = bfhi(rq.w);
#pragma unroll
        for (int e = 0; e < 8; ++e) ss += xq[ks][e] * xq[ks][e]; }
    ss += __shfl_xor(ss, 32);
    const float rs = rsqrtf(ss * (1.f / 64.f) + EPS) * (0.125f * LOG2E);
    const float prow = (float)(tq >> 6), pcol = (float)(tq & 63);
    const float* gq = C.in[7] + l * 64 + 8 * hi;
    float oq[4][8];
#pragma unroll
    for (int e = 0; e < 8; ++e) {
        const float fr_ = __builtin_amdgcn_exp2f(-13.287712379549449f * (float)(8 * hi + e) * (1.f / 16.f));
        const float ar = prow * fr_, ac = pcol * fr_;
        const float cr = __cosf(ar), sr_ = __sinf(ar), cc = __cosf(ac), sc_ = __sinf(ac);
        const float y0 = xq[0][e] * rs * gq[e], y1 = xq[1][e] * rs * gq[16 + e], y2 = xq[2][e] * rs * gq[32 + e], y3 = xq[3][e] * rs * gq[48 + e];
        oq[0][e] = y0 * cr - y1 * sr_; oq[1][e] = y0 * sr_ + y1 * cr; oq[2][e] = y2 * cc - y3 * sc_; oq[3][e] = y2 * sc_ + y3 * cc;
    }
#pragma unroll
    for (int ks = 0; ks < 4; ++ks) { u32x4 a; a.x = pk2(oq[ks][0], oq[ks][1]); a.y = pk2(oq[ks][2], oq[ks][3]); a.z = pk2(oq[ks][4], oq[ks][5]); a.w = pk2(oq[ks][6], oq[ks][7]); *(u32x4*)(qdst + ks * 512) = a; }
}
__device__ __forceinline__ void attn_softmax_pack(f32x16& S0, f32x16& S1, float& lsum, bf16x8 (&p)[4]) {
    float ls = 0.f;
#pragma unroll
    for (int i = 0; i < 16; ++i) { S0[i] = __builtin_amdgcn_exp2f(S0[i]); S1[i] = __builtin_amdgcn_exp2f(S1[i]); ls += S0[i] + S1[i]; }
    lsum += ls;
    { u32x4 a; a.x = pk2(S0[0], S0[1]); a.y = pk2(S0[2], S0[3]); a.z = pk2(S0[4], S0[5]); a.w = pk2(S0[6], S0[7]); p[0] = __builtin_bit_cast(bf16x8, a); }
    { u32x4 a; a.x = pk2(S0[8], S0[9]); a.y = pk2(S0[10], S0[11]); a.z = pk2(S0[12], S0[13]); a.w = pk2(S0[14], S0[15]); p[1] = __builtin_bit_cast(bf16x8, a); }
    { u32x4 a; a.x = pk2(S1[0], S1[1]); a.y = pk2(S1[2], S1[3]); a.z = pk2(S1[4], S1[5]); a.w = pk2(S1[6], S1[7]); p[2] = __builtin_bit_cast(bf16x8, a); }
    { u32x4 a; a.x = pk2(S1[8], S1[9]); a.y = pk2(S1[10], S1[11]); a.z = pk2(S1[12], S1[13]); a.w = pk2(S1[14], S1[15]); p[3] = __builtin_bit_cast(bf16x8, a); }
}
__device__ __forceinline__ void attn_store(bf16_t* Orow, const f32x16& O0, const f32x16& O1, float lsum, int hi) {
    const float inv = 1.f / (lsum + __shfl_xor(lsum, 32));
#pragma unroll
    for (int i4 = 0; i4 < 4; ++i4) {
        u32x2 a; a.x = pk2(O0[4 * i4] * inv, O0[4 * i4 + 1] * inv); a.y = pk2(O0[4 * i4 + 2] * inv, O0[4 * i4 + 3] * inv);
        *(u32x2*)(Orow + 8 * i4 + 4 * hi) = a;
        u32x2 c; c.x = pk2(O1[4 * i4] * inv, O1[4 * i4 + 1] * inv); c.y = pk2(O1[4 * i4 + 2] * inv, O1[4 * i4 + 3] * inv);
        *(u32x2*)(Orow + 32 + 8 * i4 + 4 * hi) = c;
    }
}
__device__ __forceinline__ void p3_attn(const Ctx& C, int l, int dummy) {
    bf16_t* P = (bf16_t*)(C.ws + WS_BIG);
    const bf16_t* VAT = (const bf16_t*)(C.ws + WS_VAT);
    int tid_ = TID_NOW(C.wv); asm volatile("" : "+v"(tid_)); const int tid = tid_, lane = tid & 63, wave = __builtin_amdgcn_readfirstlane(tid >> 6);
    const int w = wave, hi = lane >> 5, l32 = lane & 31;
    const float nMb = -8.f * LOG2E * wave_max(fabsf(C.in[7][l * 64 + lane])) * wave_max(fabsf(C.in[8][l * 64 + lane]));
    const int pm = (l32 & ~12) | ((l32 & 4) << 1) | ((l32 & 8) >> 1);
    bf16_t* Ks = (bf16_t*)C.lds;
    bf16_t* Vs = Ks + 2 * 64 * 72;
    const int sr = tid >> 3, sc = tid & 7;
    bf16_t* Qs = (bf16_t*)(C.lds + 36864) + w * 4096 + lane * 8;
    for (int u = blockIdx.x; u < 512; u += C.G) {
        int b, h, qb, kvh;
        if (C.G == 256) { const int cx = blockIdx.x & 7, cj = blockIdx.x >> 3, pr = 4 * cx + (cj >> 3); b = pr >> 1; kvh = pr & 1; qb = (cj & 7) >> 1; h = 4 * kvh + 2 * (cj & 1) + (u >> 8); }
        else { b = u >> 5; h = (u >> 2) & 7; qb = u & 3; kvh = h >> 2; }
        const int tqA = qb * 512 + w * 64 + l32;
        bf16_t* QrowA = P + (size_t)(b * SEQ + tqA) * DIN + h * 64;
        bf16_t* QrowB = QrowA + (size_t)32 * DIN;
        attn_qprep(C, l, QrowA, tqA, hi, Qs);
        attn_qprep(C, l, QrowB, tqA + 32, hi, Qs + 2048);
        const bf16_t* Kg = P + (size_t)(b * SEQ + sr) * DIN + C_KA + kvh * 64 + 8 * sc;
        const bf16_t* Vg = VAT + (size_t)((b * 2 + kvh) * 64 + sr) * SEQ + 8 * sc;
        f32x16 OA0, OA1, OB0, OB1;
#pragma unroll
        for (int i = 0; i < 16; ++i) { OA0[i] = 0.f; OA1[i] = 0.f; OB0[i] = 0.f; OB1[i] = 0.f; }
        float lsA = 0.f, lsB = 0.f;
        u32x4 kreg = *(const u32x4*)Kg, vreg = *(const u32x4*)Vg;
        __syncthreads();
        *(u32x4*)(Ks + sr * 72 + 8 * sc) = kreg; *(u32x4*)(Vs + sr * 72 + 8 * sc) = vreg;
        __syncthreads();
        for (int t = 0; t < 32; ++t) {
            const int buf = t & 1;
            if (t + 1 < 32) { kreg = *(const u32x4*)(Kg + (size_t)(t + 1) * 64 * DIN); vreg = *(const u32x4*)(Vg + (t + 1) * 64); }
            const bf16_t* Kb = Ks + buf * 64 * 72; const bf16_t* Vb = Vs + buf * 64 * 72;
            bf16x8 pA[4], pB[4];
            {   f32x16 S0, S1;
#pragma unroll
                for (int i = 0; i < 16; ++i) { S0[i] = nMb; S1[i] = nMb; }
#pragma unroll
                for (int ks = 0; ks < 4; ++ks) {
                    const bf16x8 k0 = *(const bf16x8*)(Kb + pm * 72 + 16 * ks + 8 * hi);
                    const bf16x8 k1 = *(const bf16x8*)(Kb + (32 + pm) * 72 + 16 * ks + 8 * hi);
                    const bf16x8 qv = *(const bf16x8*)(Qs + ks * 512);
                    S0 = __builtin_amdgcn_mfma_f32_32x32x16_bf16(k0, qv, S0, 0, 0, 0);
                    S1 = __builtin_amdgcn_mfma_f32_32x32x16_bf16(k1, qv, S1, 0, 0, 0);
                }
                attn_softmax_pack(S0, S1, lsA, pA);
            }
            {   f32x16 S0, S1;
#pragma unroll
                for (int i = 0; i < 16; ++i) { S0[i] = nMb; S1[i] = nMb; }
#pragma unroll
                for (int ks = 0; ks < 4; ++ks) {
                    const bf16x8 k0 = *(const bf16x8*)(Kb + pm * 72 + 16 * ks + 8 * hi);
                    const bf16x8 k1 = *(const bf16x8*)(Kb + (32 + pm) * 72 + 16 * ks + 8 * hi);
                    const bf16x8 qv = *(const bf16x8*)(Qs + 2048 + ks * 512);
                    S0 = __builtin_amdgcn_mfma_f32_32x32x16_bf16(k0, qv, S0, 0, 0, 0);
                    S1 = __builtin_amdgcn_mfma_f32_32x32x16_bf16(k1, qv, S1, 0, 0, 0);
                }
                attn_softmax_pack(S0, S1, lsB, pB);
            }
#pragma unroll
            for (int jj = 0; jj < 4; ++jj) {
                const bf16x8 v0 = *(const bf16x8*)(Vb + l32 * 72 + 16 * jj + 8 * hi);
                const bf16x8 v1 = *(const bf16x8*)(Vb + (32 + l32) * 72 + 16 * jj + 8 * hi);
                OA0 = __builtin_amdgcn_mfma_f32_32x32x16_bf16(v0, pA[jj], OA0, 0, 0, 0);
                OA1 = __builtin_amdgcn_mfma_f32_32x32x16_bf16(v1, pA[jj], OA1, 0, 0, 0);
                OB0 = __builtin_amdgcn_mfma_f32_32x32x16_bf16(v0, pB[jj], OB0, 0, 0, 0);
                OB1 = __builtin_amdgcn_mfma_f32_32x32x16_bf16(v1, pB[jj], OB1, 0, 0, 0);
            }
            if (t + 1 < 32) { *(u32x4*)(Ks + (buf ^ 1) * 64 * 72 + sr * 72 + 8 * sc) = kreg; *(u32x4*)(Vs + (buf ^ 1) * 64 * 72 + sr * 72 + 8 * sc) = vreg; }
            __syncthreads();
        }
        attn_store(QrowA, OA0, OA1, lsA, hi);
        attn_store(QrowB, OB0, OB1, lsB, hi);
    }
}

__device__ __forceinline__ void p3_natten(const Ctx& C, int l, int dummy) {
    bf16_t* P = (bf16_t*)(C.ws + WS_BIG);
    const bf16_t* VCT = (const bf16_t*)(C.ws + WS_XN + 32 * MiB);
    int tid_ = TID_NOW(C.wv); asm volatile("" : "+v"(tid_)); const int tid = tid_, lane = tid & 63, wave = __builtin_amdgcn_readfirstlane(tid >> 6); (void)tid;
    const int h = wave, q = lane & 15, Qr = lane >> 4;
    bf16_t* kt = (bf16_t*)(C.lds + h * 4608);
    bf16_t* vt = (bf16_t*)(C.lds + 36864 + h * 5120);
    float* rp = (float*)(C.lds + 81920) + h * 960;
    { const float* rpb = C.in[11] + (size_t)(l * 8 + h) * 15 * 31;
#pragma unroll
      for (int i = 0; i < 15; ++i) { const int dc = lane - 16; rp[i * 64 + lane] = (dc >= 0 && dc < 31) ? rpb[i * 31 + dc] : 0.f; } }
    for (int u = blockIdx.x; u < 2048; u += C.G) {
        int b, r, cgp;
        if (C.G == 256) { const int cx = blockIdx.x & 7, idx = (blockIdx.x >> 3) + 32 * (u >> 8); b = 2 * cx + (idx >> 7); r = (idx >> 2) & 31; cgp = idx & 3; }
        else { b = u >> 7; r = (u >> 2) & 31; cgp = u & 3; }
        const int c0 = cgp * 16;
        int kc0 = c0 - 8; kc0 = kc0 < 0 ? 0 : (kc0 > 32 ? 32 : kc0);
        int rs = r - 4; rs = rs < 0 ? 0 : (rs > 24 ? 24 : rs);
        const int c = c0 + q; int cs = c - 8; cs = cs < 0 ? 0 : (cs > 48 ? 48 : cs);
        bf16_t* qrow = P + (size_t)(b * SEQ + r * 64 + c) * DIN + C_QC + h * 64;
        bf16_t* qio = P + (size_t)(b * SEQ + r * 64 + c0 + (lane >> 3)) * DIN + C_QC + h * 64 + 8 * (lane & 7);
        { const u32x4 qa = __builtin_nontemporal_load((const u32x4*)qio), qb2 = __builtin_nontemporal_load((const u32x4*)(qio + (size_t)8 * DIN));
          *(u32x4*)(vt + (lane >> 3) * 72 + 8 * (lane & 7)) = qa; *(u32x4*)(vt + (8 + (lane >> 3)) * 72 + 8 * (lane & 7)) = qb2; }
        const bf16x8 q0 = *(const bf16x8*)(vt + q * 72 + 8 * Qr), q1 = *(const bf16x8*)(vt + q * 72 + 32 + 8 * Qr);
        const int kcolA = 8 * (q >> 2) + (q & 3);
        const bf16_t* kg = P + (size_t)(b * SEQ + rs * 64 + kc0 + (lane >> 3)) * DIN + C_KC + h * 64 + 8 * (lane & 7);
        u32x4 kr[8][4];
#pragma unroll
        for (int rr = 0; rr < 8; ++rr)
#pragma unroll
            for (int j = 0; j < 4; ++j) kr[rr][j] = *(const u32x4*)(kg + (size_t)(rr * 64 + 8 * j) * DIN);
        f32x4 S[8][2];
#pragma unroll
        for (int rr = 0; rr < 8; ++rr) {
#pragma unroll
            for (int j = 0; j < 4; ++j) *(u32x4*)(kt + (8 * j + (lane >> 3)) * 72 + 8 * (lane & 7)) = kr[rr][j];
#pragma unroll
            for (int a = 0; a < 2; ++a) {
                const bf16x8 k0 = *(const bf16x8*)(kt + (kcolA + 4 * a) * 72 + 8 * Qr), k1 = *(const bf16x8*)(kt + (kcolA + 4 * a) * 72 + 32 + 8 * Qr);
                f32x4 sx = {0.f, 0.f, 0.f, 0.f};
                sx = __builtin_amdgcn_mfma_f32_16x16x32_bf16(k0, q0, sx, 0, 0, 0);
                sx = __builtin_amdgcn_mfma_f32_16x16x32_bf16(k1, q1, sx, 0, 0, 0);
                S[rr][a] = sx;
            }
        }
        const bf16_t* vg = VCT + ((size_t)(((b * 8 + h) * 32 + rs) * 8 + (kc0 >> 3) + Qr) * 64 + q) * 8;
        bf16x8 vf[8][4];
#pragma unroll
        for (int rr = 0; rr < 8; ++rr)
#pragma unroll
            for (int d = 0; d < 4; ++d) vf[rr][d] = *(const bf16x8*)(vg + (size_t)rr * 4096 + d * 128);
        float mx = -3.0e38f;
        const int kcb = kc0 + 8 * Qr;
        bool okj[8];
#pragma unroll
        for (int j = 0; j < 8; ++j) okj[j] = (unsigned)(kcb + j - cs) < 16u;
        const float* rpl = rp + (rs - r + 7) * 64 + 16 + (kcb - c + 15);
#pragma unroll
        for (int rr = 0; rr < 8; ++rr) {
            float bia[8];
#pragma unroll
            for (int j = 0; j < 8; ++j) bia[j] = rpl[rr * 64 + j];
#pragma unroll
            for (int j = 0; j < 8; ++j) asm volatile("" : "+v"(bia[j]));
#pragma unroll
            for (int a = 0; a < 2; ++a)
#pragma unroll
                for (int i = 0; i < 4; ++i) {
                    const float sv = okj[4 * a + i] ? (S[rr][a][i] * 0.125f + bia[4 * a + i]) : -3.0e38f;
                    S[rr][a][i] = sv; mx = fmaxf(mx, sv);
                } }
        mx = fmaxf(mx, __shfl_xor(mx, 16)); mx = fmaxf(mx, __shfl_xor(mx, 32));
        float sum = 0.f;
#pragma unroll
        for (int rr = 0; rr < 8; ++rr)
#pragma unroll
            for (int a = 0; a < 2; ++a)
#pragma unroll
                for (int i = 0; i < 4; ++i) { const float pv = __builtin_amdgcn_exp2f((S[rr][a][i] - mx) * LOG2E); S[rr][a][i] = pv; sum += pv; }
        sum += __shfl_xor(sum, 16); sum += __shfl_xor(sum, 32);
        const float inv = 1.f / sum;
        f32x4 O[4];
#pragma unroll
        for (int d = 0; d < 4; ++d) O[d] = (f32x4){0.f, 0.f, 0.f, 0.f};
#pragma unroll
        for (int rr = 0; rr < 8; ++rr) {
            u32x4 pa; pa.x = pk2(S[rr][0][0], S[rr][0][1]); pa.y = pk2(S[rr][0][2], S[rr][0][3]); pa.z = pk2(S[rr][1][0], S[rr][1][1]); pa.w = pk2(S[rr][1][2], S[rr][1][3]);
            const bf16x8 pb = __builtin_bit_cast(bf16x8, pa);
#pragma unroll
            for (int d = 0; d < 4; ++d) O[d] = __builtin_amdgcn_mfma_f32_16x16x32_bf16(vf[rr][d], pb, O[d], 0, 0, 0);
        }
#pragma unroll
        for (int d = 0; d < 4; ++d) { u32x2 o; o.x = pk2(O[d][0] * inv, O[d][1] * inv); o.y = pk2(O[d][2] * inv, O[d][3] * inv); *(u32x2*)(vt + q * 72 + 16 * d + 4 * Qr) = o; }
        { const u32x4 oa = *(const u32x4*)(vt + (lane >> 3) * 72 + 8 * (lane & 7)), ob = *(const u32x4*)(vt + (8 + (lane >> 3)) * 72 + 8 * (lane & 7));
          *(u32x4*)qio = oa; *(u32x4*)(qio + (size_t)8 * DIN) = ob; }
    }
}

__device__ __forceinline__ void unpack8(const u32x4 v, float* f) { f[0] = bflo(v.x); f[1] = bfhi(v.x); f[2] = bflo(v.y); f[3] = bfhi(v.y); f[4] = bflo(v.z); f[5] = bfhi(v.z); f[6] = bflo(v.w); f[7] = bfhi(v.w); }
__device__ __forceinline__ void p8_convact(const Ctx& C, int l) {
    bf16_t* UP = (bf16_t*)(C.ws + WS_BIG);
    const bf16_t* HALO = (const bf16_t*)(C.ws + WS_VAT);
    const float* cw = C.in[15] + (size_t)l * 3 * DUP; const float* cb = C.in[16] + (size_t)l * DUP;
    int tid_ = TID_NOW(C.wv); asm volatile("" : "+v"(tid_)); const int tid = tid_, lane = tid & 63, wave = __builtin_amdgcn_readfirstlane(tid >> 6); (void)tid; (void)lane; (void)wave;
    const u32x4 zero = {0u, 0u, 0u, 0u};
    for (int it = blockIdx.x * 512 + tid; it < 1024 * 352; it += C.G * 512) {
        const int chq = it / 352, ct = it - chq * 352, ch = 1023 - chq, f = 8 * ct, row0 = ch * 32;
        float w0v[8], w1v[8], w2v[8], bvv[8], w0g[8], w1g[8], w2g[8], bgg[8];
#pragma unroll
        for (int e = 0; e < 8; ++e) { w0v[e] = cw[f + e]; w1v[e] = cw[DUP + f + e]; w2v[e] = cw[2 * DUP + f + e]; bvv[e] = cb[f + e];
            w0g[e] = cw[DFF + f + e]; w1g[e] = cw[DUP + DFF + f + e]; w2g[e] = cw[2 * DUP + DFF + f + e]; bgg[e] = cb[DFF + f + e]; }
        bf16_t* vp = UP + (size_t)row0 * DUP + f; const bf16_t* gp = vp + DFF;
        const bool first = (row0 & 2047) == 0, last = ((row0 + 32) & 2047) == 0;
        u32x4 pv = first ? zero : *(const u32x4*)(HALO + (size_t)((ch - 1) * 2 + 1) * DFF + f);
        u32x4 pg = first ? zero : *(const u32x4*)(gp - DUP);
        u32x4 cv = *(const u32x4*)vp, cgt = *(const u32x4*)gp;
        for (int r4 = 0; r4 < 32; r4 += 4) {
            u32x4 nv[4], ng[4];
#pragma unroll
            for (int k = 0; k < 4; ++k) {
                const int r = r4 + k + 1;
                if (r < 32) { nv[k] = __builtin_nontemporal_load((const u32x4*)(vp + (size_t)r * DUP)); ng[k] = __builtin_nontemporal_load((const u32x4*)(gp + (size_t)r * DUP)); }
                else { nv[k] = last ? zero : *(const u32x4*)(HALO + (size_t)((ch + 1) * 2) * DFF + f); ng[k] = last ? zero : *(const u32x4*)(gp + (size_t)32 * DUP); }
            }
#pragma unroll
            for (int k = 0; k < 4; ++k) {
                float a[8], bq[8], c[8], ga[8], gb[8], gc[8];
                unpack8(pv, a); unpack8(cv, bq); unpack8(nv[k], c); unpack8(pg, ga); unpack8(cgt, gb); unpack8(ng[k], gc);
                float o[8];
#pragma unroll
                for (int e = 0; e < 8; ++e) {
                    const float val = a[e] * w0v[e] + bq[e] * w1v[e] + c[e] * w2v[e] + bvv[e];
                    const float x = ga[e] * w0g[e] + gb[e] * w1g[e] + gc[e] * w2g[e] + bgg[e];
                    const float t2 = 1.5957691216057308f * (x + 0.044715f * x * x * x);
                    const float ge = x * __builtin_amdgcn_rcpf(1.f + __expf(-t2));
                    o[e] = ge * val;
                }
                u32x4 ov; ov.x = pk2(o[0], o[1]); ov.y = pk2(o[2], o[3]); ov.z = pk2(o[4], o[5]); ov.w = pk2(o[6], o[7]);
                *(u32x4*)(vp + (size_t)(r4 + k) * DUP) = ov;
                pv = cv; pg = cgt; cv = nv[k]; cgt = ng[k];
            }
        }
    }
}

#define XB_TMO      128
#define XB_XCNT(j)  (256  + 64 * (j))
#define XB_XSUB(j)  (1280 + 64 * (j))
#define XB_XGEN(j)  (2304 + 64 * (j))
#define XB_TOP      3328
#define XB_TOPGEN   3392
#define XCD_BAR_WORDS 3456
#define XB_SPIN_CAP (1u << 18)

__device__ __forceinline__ unsigned xb_ld(unsigned* p)              { return __hip_atomic_load(p, __ATOMIC_RELAXED, __HIP_MEMORY_SCOPE_AGENT); }
__device__ __forceinline__ unsigned xb_add(unsigned* p, unsigned v) { return __hip_atomic_fetch_add(p, v, __ATOMIC_RELAXED, __HIP_MEMORY_SCOPE_AGENT); }
__device__ __forceinline__ unsigned xb_xcc_id() { return (unsigned)__builtin_amdgcn_s_getreg((3 << 11) | 20) & 0xFu; }
#define XB_SPIN(cond, bar) do { unsigned _sp = 0; while (cond) { __builtin_amdgcn_s_sleep(1); \
    if ((++_sp & 255u) == 0u) { if (xb_ld(&(bar)[XB_TMO])) break; if (_sp > XB_SPIN_CAP) { atomicAdd(&(bar)[XB_TMO], 1u); break; } } } } while (0)

struct XcdBarrier {
    unsigned* bar; unsigned x; int wv;
    volatile LAS unsigned* st;
};

__device__ __forceinline__ XcdBarrier xcd_barrier_post(unsigned* bar, volatile LAS unsigned* st) {
    XcdBarrier b; b.bar = bar; b.x = xb_xcc_id(); b.st = st; b.wv = 0;
    if (threadIdx.x == 0) (void)xb_add(&bar[XB_XCNT(b.x)], 1u);
    return b;
}
__device__ __forceinline__ void xcd_barrier_complete(unsigned* bar, unsigned x, unsigned& nloc, unsigned& nx) {
    const unsigned G = gridDim.x * gridDim.y * gridDim.z;
    unsigned sum, cnt, mine, sp = 0u;
    for (;;) {
        sum = 0u; cnt = 0u; mine = 0u;
#pragma unroll
        for (unsigned j = 0; j < 16; ++j) { const unsigned c = xb_ld(&bar[XB_XCNT(j)]); sum += c; cnt += (c > 0u) ? 1u : 0u; mine = (j == x) ? c : mine; }
        if (sum == G) break;
        __builtin_amdgcn_s_sleep(1);
        if ((++sp & 255u) == 0u) { if (xb_ld(&bar[XB_TMO])) break; if (sp > XB_SPIN_CAP) { atomicAdd(&bar[XB_TMO], 1u); break; } }
    }
    nloc = mine > 0u ? mine : 1u; nx = cnt > 0u ? cnt : 1u;
}

__device__ __forceinline__ void xcd_barrier(const XcdBarrier& b) {
    asm volatile("s_waitcnt vmcnt(0)" ::: "memory");
    __syncthreads();
    int xb_t = TID_NOW(b.wv); asm volatile("" : "+v"(xb_t));
    if (xb_t == 0) {
        unsigned* bar = b.bar;
        __builtin_amdgcn_s_waitcnt(0);
        unsigned nloc = b.st[0], nx = b.st[1];
        if (nloc == 0u) { xcd_barrier_complete(bar, b.x, nloc, nx); b.st[0] = nloc; b.st[1] = nx; }
        const unsigned old = xb_add(&bar[XB_XSUB(b.x)], 1u);
        const unsigned gen = old / nloc;
        if (old + 1u == (gen + 1u) * nloc) {
            __builtin_amdgcn_fence(__ATOMIC_RELEASE, "agent");
            asm volatile("s_waitcnt vmcnt(0)" ::: "memory");
            const unsigned og = xb_add(&bar[XB_TOP], 1u);
            const unsigned tg = og / nx;
            if (og + 1u == (tg + 1u) * nx) xb_add(&bar[XB_TOPGEN], 1u);
            else XB_SPIN(xb_ld(&bar[XB_TOPGEN]) == tg, bar);
            __builtin_amdgcn_fence(__ATOMIC_ACQUIRE, "agent");
            xb_add(&bar[XB_XGEN(b.x)], 1u);
            asm volatile("s_waitcnt vmcnt(0)" ::: "memory");
        } else {
            XB_SPIN(xb_ld(&bar[XB_XGEN(b.x)]) == gen, bar);
            __builtin_amdgcn_fence(__ATOMIC_ACQUIRE, "agent");
            asm volatile("s_waitcnt vmcnt(0)" ::: "memory");
        }
    }
    __syncthreads();
}

#ifndef GEMM_MASK
#define GEMM_MASK 63
#endif
#define GEMM_CALL1 if ((GEMM_MASK >> 0) & 1)
#define GEMM_CALL2 if ((GEMM_MASK >> 1) & 1)
#define GEMM_CALL3 if ((GEMM_MASK >> 2) & 1)
#define GEMM_CALL4 if ((GEMM_MASK >> 3) & 1)
#define GEMM_CALL5 if ((GEMM_MASK >> 4) & 1)
#define GEMM_CALL6 if ((GEMM_MASK >> 5) & 1)
struct Args { const float* in[18]; float* out; unsigned char* ws; int ph_lo, ph_hi; };
constexpr int N_PHASES = 21;

__global__ void __launch_bounds__(512, 2) fwd_mega(Args args) {
    extern __shared__ __attribute__((aligned(16))) unsigned char lds[];
    cg::grid_group grid = cg::this_grid();
    Ctx C;
#pragma unroll
    for (int i = 0; i < 18; ++i) C.in[i] = args.in[i];
    C.out = args.out; C.ws = args.ws; C.lds = lds; C.G = gridDim.x; C.wv = __builtin_amdgcn_readfirstlane(threadIdx.x >> 6);
    PG8_LAS unsigned char* ldsg = (PG8_LAS unsigned char*)lds;
    volatile LAS unsigned* bst = (volatile LAS unsigned*)(ldsg + 131072);
    if (threadIdx.x < 64) bst[threadIdx.x] = 0u;
    __syncthreads();
    XcdBarrier xbar = xcd_barrier_post((unsigned*)(args.ws + 4096 * 4), bst);
    xbar.wv = C.wv;
    bf16_t* Wb = (bf16_t*)(C.ws + WS_W);
    bf16_t* XN = (bf16_t*)(C.ws + WS_XN);
    bf16_t* BIG = (bf16_t*)(C.ws + WS_BIG);
    if (args.ph_lo < 0) grid.sync();
    for (int ph = args.ph_lo; ph < args.ph_hi; ++ph) {
        if (ph == 0) {
#ifndef NO_P0
 p0_prologue(C);
#endif
 }
        else {
            const int l = (ph - 1) / 10, k = (ph - 1) % 10;
            if (k == 0) {
                __syncthreads();
                pg8::Gemm g{XN, Wb + OW_IN + (size_t)l * DIN * 1024, 1024, 1024, 1024, C.wv};
                pg8::StdSched S{128, 23, C.G, (int)blockIdx.x, (size_t)256 * 1024 * 2, (size_t)256 * 1024 * 2, WGM_BIG};
                EpiProj E{BIG, C.in[6] + l * 3072, lds};
                GEMM_CALL1 pg8::gemm_phase<EpiProj, pg8::StdSched, true, true>(ldsg, g, S, E);
#if defined(DUP_P1)
                __syncthreads(); pg8::gemm_phase<EpiProj, pg8::StdSched, true, true>(ldsg, g, S, E);
#endif
            } else if (k == 1) {
                __syncthreads();
#ifndef NO_P2
                p2_prep(C, l);
#endif
            } else if (k == 2) {
                __syncthreads();
#ifdef ECHO_SUB
#define ECHO_HERE(id) do { xcd_barrier(xbar); if (ECHO_SUB == (id)) { const unsigned long long e1 = __builtin_amdgcn_s_memrealtime(); while (__builtin_amdgcn_s_memrealtime() < e1 + (e1 - e0)) __builtin_amdgcn_s_sleep(8); } e0 = __builtin_amdgcn_s_memrealtime(); } while (0)
                unsigned long long e0 = __builtin_amdgcn_s_memrealtime();
#else
#define ECHO_HERE(id)
#endif
                p3_attn(C, l, 0);
                ECHO_HERE(1);
                p3_natten(C, l, 0);
                ECHO_HERE(2);
                __syncthreads();
                pg8::Gemm g{(const bf16_t*)(C.ws + WS_XN), Wb + OW_POOL + (size_t)l * 512 * 512, 512, 512, 512, C.wv};
                pg8::StdSched S{128, 2, C.G, (int)blockIdx.x, (size_t)256 * 512 * 2, (size_t)256 * 512 * 2, WGM_SMALL};
                EpiPlain E{BIG + C_POOL, DIN, lds};
                GEMM_CALL2 pg8::gemm_phase<EpiPlain, pg8::StdSched, true, true>(ldsg, g, S, E);
            } else if (k == 3) {
                __syncthreads();
                pg8::Gemm g{BIG, Wb + OW_BR + (size_t)l * 3 * 1024 * 512, DIN, 512, 512, C.wv};
                BranchSched S{C.G, (int)blockIdx.x};
                EpiBranch E{BIG, XN, lds};
                GEMM_CALL3 pg8::gemm_phase<EpiBranch, BranchSched, true, true>(ldsg, g, S, E);
            } else if (k == 4) {
                __syncthreads();
                pg8::Gemm g{XN, Wb + OW_OUT + (size_t)l * 1024 * 1024, 1024, 1024, 1024, C.wv};
                pg8::StdSched S{128, 4, C.G, (int)blockIdx.x, (size_t)256 * 1024 * 2, (size_t)256 * 1024 * 2, WGM_SMALL};
                EpiPlain E{BIG, DM, lds};
                GEMM_CALL4 pg8::gemm_phase<EpiPlain, pg8::StdSched, true, true>(ldsg, g, S, E);
            } else if (k == 5) {
                int tid_ = TID_NOW(C.wv); asm volatile("" : "+v"(tid_)); const int lane = tid_ & 63, gw = blockIdx.x * 8 + __builtin_amdgcn_readfirstlane(tid_ >> 6), NGW = C.G * 8;
                const float* xin = (l == 0) ? C.in[0] : C.out;
                for (int m = gw; m < NTOK; m += 2 * NGW)
                    resnorm_rows<2>(BIG + (size_t)m * DM, xin + (size_t)m * DM, C.in[2] + l * DM, C.out + (size_t)m * DM, C.in[3] + l * DM, XN + (size_t)m * DM, (size_t)NGW * DM, lane);
            } else if (k == 6) {
                __syncthreads();
                pg8::Gemm g{XN, Wb + OW_UP + (size_t)l * DUP * 1024, 1024, 1024, 1024, C.wv};
                pg8::StdSched S{128, 22, C.G, (int)blockIdx.x, (size_t)256 * 1024 * 2, (size_t)256 * 1024 * 2, WGM_BIG};
                EpiUp E{BIG, (bf16_t*)(C.ws + WS_VAT), lds};
                GEMM_CALL5 pg8::gemm_phase<EpiUp, pg8::StdSched, true, true>(ldsg, g, S, E);
            } else if (k == 7) {
#ifndef NO_P8
                p8_convact(C, l);
#endif
            } else if (k == 8) {
                __syncthreads();
                pg8::Gemm g{BIG, Wb + OW_DN + (size_t)l * 1024 * DFF, DUP, DFF, DFF, C.wv};
                pg8::StdSched S{128, 4, C.G, (int)blockIdx.x, (size_t)256 * DUP * 2, (size_t)256 * DFF * 2, WGM_SMALL};
                EpiPlain E{XN, DM, lds};
                GEMM_CALL6 pg8::gemm_phase<EpiPlain, pg8::StdSched, true, true>(ldsg, g, S, E);
            } else {
                int tid_ = TID_NOW(C.wv); asm volatile("" : "+v"(tid_)); const int lane = tid_ & 63, gw = blockIdx.x * 8 + __builtin_amdgcn_readfirstlane(tid_ >> 6), NGW = C.G * 8;
                const float* gnext = (l == 0) ? (C.in[1] + DM) : nullptr;
                for (int m = gw; m < NTOK; m += 2 * NGW)
                    resnorm_rows<2>(XN + (size_t)m * DM, C.out + (size_t)m * DM, C.in[4] + l * DM, C.out + (size_t)m * DM, gnext, XN + (size_t)m * DM, (size_t)NGW * DM, lane);
            }
        }
        if (ph + 1 < args.ph_hi) xcd_barrier(xbar);
    }
}

#ifndef MK_N_LAUNCHES
#define MK_N_LAUNCHES 1
#endif
extern "C" void kernel_launch(void* const* d_in, const int* in_sizes, int n_in, void* d_out, int out_size, void* d_ws, size_t ws_size, hipStream_t stream) {
    static int grid = 0;
    if (grid == 0) {
        if (n_in != 18 || out_size != NTOK * DM || ws_size < WS_END) { fprintf(stderr, "kernel_launch: unexpected shapes (n_in %d out %d ws %zu)\n", n_in, out_size, ws_size); grid = -1; return; }
        int dev = 0, cus = 0, per_cu = 0;
        hipGetDevice(&dev); hipDeviceGetAttribute(&cus, hipDeviceAttributeMultiprocessorCount, dev);
        if (hipFuncSetAttribute((const void*)fwd_mega, hipFuncAttributeMaxDynamicSharedMemorySize, LDS_BYTES) != hipSuccess) { fprintf(stderr, "kernel_launch: hipFuncSetAttribute failed\n"); grid = -1; return; }
        if (hipOccupancyMaxActiveBlocksPerMultiprocessor(&per_cu, (const void*)fwd_mega, 512, LDS_BYTES) != hipSuccess || per_cu < 1) { fprintf(stderr, "kernel_launch: occupancy query says %d\n", per_cu); per_cu = 1; }
        (void)hipGetLastError();
        grid = cus;
    }
    if (grid < 0) return;
    if (hipMemsetAsync(d_ws, 0, 1 << 20, stream) != hipSuccess) { fprintf(stderr, "kernel_launch: memset failed\n"); return; }
    Args a{};
    for (int i = 0; i < 18; ++i) a.in[i] = (const float*)d_in[i];
    a.out = (float*)d_out; a.ws = (unsigned char*)d_ws;
    if (MK_N_LAUNCHES == 1) {
        a.ph_lo = 0; a.ph_hi = N_PHASES;
        void* kargs[] = {&a};
        hipError_t e = hipLaunchCooperativeKernel((const void*)fwd_mega, dim3(grid), dim3(512), kargs, LDS_BYTES, stream);
        if (e != hipSuccess) fprintf(stderr, "cooperative launch failed: %s (grid %d)\n", hipGetErrorString(e), grid);
    } else {
        for (int ph = 0; ph < N_PHASES; ++ph) { a.ph_lo = ph; a.ph_hi = ph + 1; hipLaunchKernelGGL(fwd_mega, dim3(grid), dim3(512), LDS_BYTES, stream, a); }
    }
}
```

```cpp
#include <hip/hip_runtime.h>
#include <hip/hip_cooperative_groups.h>
#include <cstdio>
#include <cstdint>
namespace cg = cooperative_groups;

#ifndef WGM_BIG
#define WGM_BIG 4
#endif
#ifndef WGM_SMALL
#define WGM_SMALL 2
#endif
__device__ __forceinline__ int lane_now() { int l_; asm volatile("v_mbcnt_lo_u32_b32 %0, -1, 0\n\tv_mbcnt_hi_u32_b32 %0, -1, %0" : "=v"(l_)); return l_; }
#define TID_NOW(wv) (((wv) << 6) | lane_now())
namespace pg8 {
#define PG8_LAS __attribute__((address_space(3)))
typedef unsigned short bf16_t;
typedef short bf16x8 __attribute__((ext_vector_type(8)));
typedef float f32x4 __attribute__((ext_vector_type(4)));
typedef unsigned u32x4 __attribute__((ext_vector_type(4)));
constexpr int BM = 256, BK = 64, HALF = 128, HTB = HALF * BK * 2, STAGE_BYTES = 8 * HTB, NXCD = 8;

__host__ __device__ __forceinline__ int lds_byte(int r, int c) { const int st = (r >> 4) * 2 + (c >> 5), rr = r & 15, cc = c & 31, ob = rr * 64 + cc * 2; return st * 1024 + (ob ^ (((ob >> 9) & 1) << 5)); }
__host__ __device__ __forceinline__ void stage_rc(int b, int& R, int& C) { const int st = b / 1024, sb = b % 1024, swz = sb ^ (((sb >> 9) & 1) << 5); R = (st >> 1) * 16 + swz / 64; C = (st & 1) * 32 + (swz % 64) / 2; }
__host__ __device__ __forceinline__ int perm32(int rho) { const int n = rho >> 4, i = rho & 15; return 8 * (i >> 2) + 4 * n + (i & 3); }

struct Unit { int pm, pn, n; size_t aoff, boff; };
struct Gemm { const bf16_t* A; const bf16_t* Bt; int lda, ldb, K, wv; };

__device__ __forceinline__ void tile_of(int L, int nM, int nN, int WGM, int& pm, int& pn) {
    const int nwg = nM * nN; int wgid = L; { const int q = nwg / NXCD, r = nwg % NXCD, xcd = wgid % NXCD, off = wgid / NXCD; wgid = (xcd < r ? xcd * (q + 1) : r * (q + 1) + (xcd - r) * q) + off; }
    const int nig = WGM * nN, gid = wgid / nig, fm = gid * WGM, gsz = (nM - fm) < WGM ? (nM - fm) : WGM;
    pm = fm + ((wgid % nig) % gsz); pn = (wgid % nig) / gsz;
}
struct StdSched {
    int nM, nN, G, c; size_t astep, bstep; int wgm;
    __device__ __forceinline__ bool next(int i, Unit& u) const {
        const long L = (long)i * G + c; if (L >= (long)nM * nN) return false;
        tile_of((int)L, nM, nN, wgm, u.pm, u.pn); u.n = 0; u.aoff = (size_t)u.pm * astep; u.boff = (size_t)u.pn * bstep; return true;
    }
    __device__ __forceinline__ void a_ready(const Unit&) const {}
    __device__ __forceinline__ void done(const Unit&) const {}
};
__device__ __forceinline__ unsigned cvt_pk_bf16(float lo, float hi) { unsigned r; asm volatile("v_cvt_pk_bf16_f32 %0, %1, %2" : "=v"(r) : "v"(lo), "v"(hi)); return r; }
template <class Epi, class Sched, bool ALIGN_EPI = false, bool SP2 = false>
__device__ __forceinline__ void gemm_phase(PG8_LAS unsigned char* lds, const Gemm g, const Sched& S, const Epi& E) {
    int tid_ = TID_NOW(g.wv); asm volatile("" : "+v"(tid_));
    const int tid = tid_, wid = __builtin_amdgcn_readfirstlane(tid >> 6), lane = tid & 63, wr = wid >> 2, wc = wid & 3, fr = lane & 15, fq = lane >> 4;
    const int K = g.K, nt = K / BK;
    unsigned voffA[2], voffB[2];
#pragma unroll
    for (int i = 0; i < 2; ++i) { int R, C; stage_rc(tid * 16 + i * 8192, R, C); const int Rb = Epi::PERM ? ((R & ~31) + perm32(R & 31)) : R;
        voffA[i] = (unsigned)(R * g.lda + C) * 2u; voffB[i] = (unsigned)(Rb * g.ldb + C) * 2u; }
    const size_t kstep = (size_t)(BK * 2);
    const size_t hstepA = (size_t)HALF * g.lda * 2, hstepB = (size_t)HALF * g.ldb * 2;
    const unsigned ldsw = (unsigned)wid * 1024u;
    const int aoff = lds_byte(wr * 64 + fr, fq * 8), boff = lds_byte(wc * 32 + fr, fq * 8);
#define PG8_SA(b, h) (((b) * 2 + (h)) * HTB)
#define PG8_SB(b, h) ((4 + (b) * 2 + (h)) * HTB)
#define PG8_STAGE(bufoff, gbase, voff) do { _Pragma("unroll") for (int _i = 0; _i < 2; ++_i) \
        __builtin_amdgcn_global_load_lds((const unsigned*)((const char*)(gbase) + (voff)[_i]), (PG8_LAS unsigned*)(lds + (bufoff) + ldsw + _i * 8192), 16, 0, 0); } while (0)
#define PG8_LDA(dst, b, h) do { _Pragma("unroll") for (int m = 0; m < 4; ++m) _Pragma("unroll") for (int k = 0; k < 2; ++k) dst[m][k] = *(const PG8_LAS bf16x8*)(lds + PG8_SA(b, h) + aoff + m * 2048 + k * 1024); } while (0)
#define PG8_LDB(dst, b, h) do { _Pragma("unroll") for (int n = 0; n < 2; ++n) _Pragma("unroll") for (int k = 0; k < 2; ++k) dst[n][k] = *(const PG8_LAS bf16x8*)(lds + PG8_SB(b, h) + boff + n * 2048 + k * 1024); } while (0)
#define PG8_MMA(ai, bj, At, Bt) do { __builtin_amdgcn_s_setprio(1); _Pragma("unroll") for (int m = 0; m < 4; ++m) _Pragma("unroll") for (int n = 0; n < 2; ++n) _Pragma("unroll") for (int k = 0; k < 2; ++k) \
        acc[ai][bj][m][n] = __builtin_amdgcn_mfma_f32_16x16x32_bf16(Bt[n][k], At[m][k], acc[ai][bj][m][n], 0, 0, 0); __builtin_amdgcn_s_setprio(0); } while (0)
#define PG8_WAIT_V(n) asm volatile("s_waitcnt vmcnt(" #n ")" ::: "memory")
#define PG8_WAIT_L(n) asm volatile("s_waitcnt lgkmcnt(" #n ")" ::: "memory")
#define PG8_BAR __builtin_amdgcn_s_barrier()
#define PG8_SCHED __builtin_amdgcn_sched_barrier(0)
    Unit cur, nxt; int ui = 0;
    if (!S.next(0, cur)) return;
    f32x4 acc[2][2][4][2];
#pragma unroll
    for (int a = 0; a < 2; ++a)
#pragma unroll
        for (int b = 0; b < 2; ++b)
#pragma unroll
            for (int m = 0; m < 4; ++m)
#pragma unroll
                for (int n = 0; n < 2; ++n) acc[a][b][m][n] = (f32x4){0.f, 0.f, 0.f, 0.f};
    bf16x8 At[4][2], B0[2][2], B1[2][2];
    const char* cA = (const char*)g.A + cur.aoff; const char* cB = (const char*)g.Bt + cur.boff;
    S.a_ready(cur);
    if constexpr (SP2) {
        PG8_STAGE(PG8_SB(0, 0), cB, voffB); PG8_STAGE(PG8_SB(0, 1), cB + hstepB, voffB); PG8_STAGE(PG8_SA(0, 0), cA, voffA); PG8_STAGE(PG8_SA(0, 1), cA + hstepA, voffA);
        if (wr == 1) PG8_BAR;
        PG8_WAIT_V(2); PG8_BAR;
        PG8_STAGE(PG8_SB(1, 0), cB + kstep, voffB); PG8_STAGE(PG8_SA(1, 0), cA + kstep, voffA); PG8_STAGE(PG8_SB(1, 1), cB + hstepB + kstep, voffB);
        PG8_WAIT_V(6); PG8_BAR;
    } else {
        PG8_STAGE(PG8_SB(0, 0), cB, voffB); PG8_STAGE(PG8_SA(0, 0), cA, voffA); PG8_STAGE(PG8_SB(0, 1), cB + hstepB, voffB); PG8_STAGE(PG8_SA(0, 1), cA + hstepA, voffA);
        if (wr == 1) PG8_BAR;
        PG8_WAIT_V(4); PG8_BAR;
        PG8_STAGE(PG8_SB(1, 0), cB + kstep, voffB); PG8_STAGE(PG8_SA(1, 0), cA + kstep, voffA); PG8_STAGE(PG8_SB(1, 1), cB + hstepB + kstep, voffB);
        PG8_WAIT_V(6); PG8_BAR;
    }
    for (;;) {
        const bool has_next = S.next(ui + 1, nxt);
        const char* nA = has_next ? (const char*)g.A + nxt.aoff : cA; const char* nB = has_next ? (const char*)g.Bt + nxt.boff : cB;
        for (int t = 0; t < nt; t += 2) {
            const bool last = (t == nt - 2);
            const char* a1 = cA + (size_t)(t + 1) * kstep;
            const char* a2 = last ? nA : cA + (size_t)(t + 2) * kstep; const char* b2 = last ? nB : cB + (size_t)(t + 2) * kstep;
            const char* a3 = a2 + kstep; const char* b3 = b2 + kstep;
            if (last && has_next) S.a_ready(nxt);
            if constexpr (SP2) {
            PG8_LDB(B0, 0, 0); PG8_LDB(B1, 0, 1); PG8_SCHED; PG8_LDA(At, 0, 0); PG8_STAGE(PG8_SA(1, 1), a1 + hstepA, voffA);
            PG8_WAIT_V(8); PG8_WAIT_L(0); PG8_BAR; PG8_MMA(0, 0, At, B0); PG8_MMA(0, 1, At, B1); PG8_BAR; PG8_SCHED;
            PG8_LDA(At, 0, 1); PG8_STAGE(PG8_SB(0, 0), b2, voffB); PG8_STAGE(PG8_SB(0, 1), b2 + hstepB, voffB); PG8_STAGE(PG8_SA(0, 0), a2, voffA);
            PG8_WAIT_V(8); PG8_WAIT_L(0); PG8_BAR; PG8_MMA(1, 0, At, B0); PG8_MMA(1, 1, At, B1); PG8_BAR; PG8_SCHED;
            PG8_LDB(B0, 1, 0); PG8_LDB(B1, 1, 1); PG8_SCHED; PG8_LDA(At, 1, 0); PG8_STAGE(PG8_SA(0, 1), a2 + hstepA, voffA);
            PG8_WAIT_V(8); PG8_WAIT_L(0); PG8_BAR; PG8_MMA(0, 0, At, B0); PG8_MMA(0, 1, At, B1); PG8_BAR; PG8_SCHED;
            PG8_LDA(At, 1, 1); PG8_STAGE(PG8_SB(1, 0), b3, voffB); PG8_STAGE(PG8_SB(1, 1), b3 + hstepB, voffB); PG8_STAGE(PG8_SA(1, 0), a3, voffA);
            PG8_WAIT_V(8); PG8_WAIT_L(0); PG8_BAR; PG8_MMA(1, 0, At, B0); PG8_MMA(1, 1, At, B1); PG8_BAR; PG8_SCHED;
            } else {
            PG8_LDB(B0, 0, 0); PG8_SCHED; PG8_LDA(At, 0, 0); PG8_STAGE(PG8_SA(1, 1), a1 + hstepA, voffA);
            PG8_WAIT_L(8); PG8_BAR; PG8_WAIT_L(0); PG8_MMA(0, 0, At, B0); PG8_BAR; PG8_SCHED;
            PG8_LDB(B1, 0, 1); PG8_STAGE(PG8_SB(0, 0), b2, voffB);
            PG8_BAR; PG8_WAIT_L(0); PG8_MMA(0, 1, At, B1); PG8_BAR;
            PG8_LDA(At, 0, 1); PG8_STAGE(PG8_SA(0, 0), a2, voffA);
            PG8_BAR; PG8_WAIT_L(0); PG8_MMA(1, 0, At, B0); PG8_BAR; PG8_SCHED;
            PG8_STAGE(PG8_SB(0, 1), b2 + hstepB, voffB);
            PG8_WAIT_V(6); PG8_BAR; PG8_MMA(1, 1, At, B1); PG8_BAR;
            PG8_LDB(B0, 1, 0); PG8_SCHED; PG8_LDA(At, 1, 0); PG8_STAGE(PG8_SA(0, 1), a2 + hstepA, voffA);
            PG8_WAIT_L(8); PG8_BAR; PG8_WAIT_L(0); PG8_MMA(0, 0, At, B0); PG8_BAR; PG8_SCHED;
            PG8_LDB(B1, 1, 1); PG8_STAGE(PG8_SB(1, 0), b3, voffB);
            PG8_BAR; PG8_WAIT_L(0); PG8_MMA(0, 1, At, B1); PG8_BAR;
            PG8_LDA(At, 1, 1); PG8_STAGE(PG8_SA(1, 0), a3, voffA);
            PG8_BAR; PG8_WAIT_L(0); PG8_MMA(1, 0, At, B0); PG8_BAR; PG8_SCHED;
            PG8_STAGE(PG8_SB(1, 1), b3 + hstepB, voffB);
            PG8_WAIT_V(6); PG8_BAR; PG8_MMA(1, 1, At, B1); PG8_BAR;
            }
        }
        if constexpr (ALIGN_EPI) { if (wr == 0) PG8_BAR; }
        bool fin_ = true;
        if constexpr (Epi::KEEP) { fin_ = E.run(acc, cur, wr, wc, fr, fq); } else if constexpr (!Epi::AFTER_DRAIN) { E(acc, cur, wr, wc, fr, fq); S.done(cur); }
        if (!has_next) break;
        if (fin_) {
#pragma unroll
        for (int a = 0; a < 2; ++a)
#pragma unroll
            for (int b = 0; b < 2; ++b)
#pragma unroll
                for (int m = 0; m < 4; ++m)
#pragma unroll
                    for (int n = 0; n < 2; ++n) acc[a][b][m][n] = (f32x4){0.f, 0.f, 0.f, 0.f};
        }
        cur = nxt; cA = nA; cB = nB; ++ui;
        if constexpr (ALIGN_EPI) { if (wr == 1) PG8_BAR; }
    }
    PG8_WAIT_V(0);
    if constexpr (!ALIGN_EPI) { if (wr == 0) PG8_BAR; }
    PG8_BAR;
    if constexpr (Epi::AFTER_DRAIN) { E.fused(acc, cur, wr, wc, fr, fq, lds, wid, lane); S.done(cur); }
#undef PG8_SA
#undef PG8_SB
#undef PG8_STAGE
#undef PG8_LDA
#undef PG8_LDB
#undef PG8_MMA
#undef PG8_WAIT_V
#undef PG8_WAIT_L
#undef PG8_BAR
#undef PG8_SCHED
}
}

typedef unsigned short bf16_t;
typedef short bf16x8 __attribute__((ext_vector_type(8)));
typedef float f32x4 __attribute__((ext_vector_type(4)));
typedef float f32x16 __attribute__((ext_vector_type(16)));
typedef unsigned u32x4 __attribute__((ext_vector_type(4)));
typedef unsigned u32x2 __attribute__((ext_vector_type(2)));
#define LAS __attribute__((address_space(3)))

constexpr int NTOK = 32768, DM = 1024, SEQ = 2048, DIN = 5888, DFF = 2816, DUP = 5632;
constexpr int C_KA = 512, C_VA = 640, C_POOL = 768, C_QC = 1280, C_KC = 1792, C_VC = 2304, C_GATE = 2816;
constexpr float EPS = 1e-6f, LOG2E = 1.4426950408889634f;
constexpr size_t MiB = (size_t)1 << 20;
constexpr size_t WS_W = 1 * MiB;
constexpr size_t WS_XN = 68 * MiB;
constexpr size_t WS_BIG = 132 * MiB;
constexpr size_t WS_VAT = 500 * MiB;
constexpr size_t WS_END = 511 * MiB;
constexpr size_t OW_IN = 0, OW_BR = 12058624, OW_OUT = 15204352, OW_UP = 17301504, OW_DN = 28835840, OW_POOL = 34603008;
constexpr int LDS_BYTES = 131072 + 1024 + 8 * 2304;

__device__ __forceinline__ float bf2f(unsigned v) { return __uint_as_float(v << 16); }
__device__ __forceinline__ float bflo(unsigned u) { return __uint_as_float(u << 16); }
__device__ __forceinline__ float bfhi(unsigned u) { return __uint_as_float(u & 0xffff0000u); }
__device__ __forceinline__ unsigned pk2(float lo, float hi) { return pg8::cvt_pk_bf16(lo, hi); }
__device__ __forceinline__ void unpack8(const u32x4 v, float* f);
__device__ __forceinline__ float wave_sum(float v) {
#pragma unroll
    for (int o = 1; o < 64; o <<= 1) v += __shfl_xor(v, o);
    return v;
}
__device__ __forceinline__ float wave_max(float v) {
#pragma unroll
    for (int o = 1; o < 64; o <<= 1) v = fmaxf(v, __shfl_xor(v, o));
    return v;
}

template <bool NT = false>
__device__ __forceinline__ void stage_store2(bf16_t* tw, int fr, int fq, int lane, const u32x4 w0, const u32x4 w1, bf16_t* g0) {
    *(u32x4*)(tw + fr * 72 + fq * 8) = w0; *(u32x4*)(tw + fr * 72 + 32 + fq * 8) = w1;
    const u32x4 r0 = *(const u32x4*)(tw + (lane >> 2) * 72 + (lane & 3) * 8);
    const u32x4 r1 = *(const u32x4*)(tw + (lane >> 2) * 72 + 32 + (lane & 3) * 8);
    if (NT) { __builtin_nontemporal_store(r0, (u32x4*)g0); __builtin_nontemporal_store(r1, (u32x4*)(g0 + 128)); }
    else { *(u32x4*)g0 = r0; *(u32x4*)(g0 + 128) = r1; }
}
__device__ __forceinline__ void stage_load2(bf16_t* tw, int fr, int fq, int lane, const bf16_t* g0, u32x4& w0, u32x4& w1) {
    const u32x4 r0 = __builtin_nontemporal_load((const u32x4*)g0), r1 = __builtin_nontemporal_load((const u32x4*)(g0 + 128));
    *(u32x4*)(tw + (lane >> 2) * 72 + (lane & 3) * 8) = r0; *(u32x4*)(tw + (lane >> 2) * 72 + 32 + (lane & 3) * 8) = r1;
    w0 = *(const u32x4*)(tw + fr * 72 + fq * 8); w1 = *(const u32x4*)(tw + fr * 72 + 32 + fq * 8);
}
constexpr int EPI_LDS_OFF = 131072 + 1024, EPI_LDS_WAVE = 2304;

struct EpiPlain {
    static constexpr bool PERM = true, AFTER_DRAIN = false, KEEP = false;
    bf16_t* O; int ldc; unsigned char* elds;
    __device__ __forceinline__ void operator()(const f32x4 (&acc)[2][2][4][2], const pg8::Unit& u, int wr, int wc, int fr, int fq) const {
        const int lane = fq * 16 + fr;
        bf16_t* tw = (bf16_t*)(elds + EPI_LDS_OFF + (wr * 4 + wc) * EPI_LDS_WAVE);
        bf16_t* gq = O + (size_t)(u.pm * 256 + wr * 64 + (lane >> 2)) * ldc + u.pn * 256 + wc * 32 + (lane & 3) * 8;
#pragma unroll
        for (int ai = 0; ai < 2; ++ai)
#pragma unroll
            for (int m = 0; m < 4; ++m) { u32x4 w[2];
#pragma unroll
                for (int bj = 0; bj < 2; ++bj) { const f32x4 v0 = acc[ai][bj][m][0], v1 = acc[ai][bj][m][1];
                    w[bj].x = pk2(v0[0], v0[1]); w[bj].y = pk2(v0[2], v0[3]); w[bj].z = pk2(v1[0], v1[1]); w[bj].w = pk2(v1[2], v1[3]); }
                stage_store2(tw, fr, fq, lane, w[0], w[1], gq + (size_t)(ai * 128 + m * 16) * ldc); }
    }
};
struct EpiProj {
    static constexpr bool PERM = true, AFTER_DRAIN = false, KEEP = false;
    bf16_t* O; const float* bgate; unsigned char* elds;
    __device__ __forceinline__ void operator()(const f32x4 (&acc)[2][2][4][2], const pg8::Unit& u, int wr, int wc, int fr, int fq) const {
        const int col0 = u.pn * 256 + wc * 32 + 8 * fq, lane = fq * 16 + fr;
        bf16_t* tw = (bf16_t*)(elds + EPI_LDS_OFF + (wr * 4 + wc) * EPI_LDS_WAVE);
        bf16_t* gq = O + (size_t)(u.pm * 256 + wr * 64 + (lane >> 2)) * DIN + u.pn * 256 + wc * 32 + (lane & 3) * 8;
        const bool gate = (u.pn >= 11);
        f32x4 bv[2][2];
#pragma unroll
        for (int bj = 0; bj < 2; ++bj)
#pragma unroll
            for (int n = 0; n < 2; ++n) bv[bj][n] = gate ? *(const f32x4*)(bgate + (col0 - C_GATE) + bj * 128 + 4 * n) : (f32x4){0.f, 0.f, 0.f, 0.f};
#pragma unroll
        for (int ai = 0; ai < 2; ++ai)
#pragma unroll
            for (int m = 0; m < 4; ++m) { u32x4 w[2];
#pragma unroll
                for (int bj = 0; bj < 2; ++bj) { f32x4 v0 = acc[ai][bj][m][0], v1 = acc[ai][bj][m][1];
                    if (gate) {
#pragma unroll
                        for (int j = 0; j < 4; ++j) { v0[j] = __builtin_amdgcn_rcpf(1.f + __expf(-(v0[j] + bv[bj][0][j]))); v1[j] = __builtin_amdgcn_rcpf(1.f + __expf(-(v1[j] + bv[bj][1][j]))); }
                    }
                    w[bj].x = pk2(v0[0], v0[1]); w[bj].y = pk2(v0[2], v0[3]); w[bj].z = pk2(v1[0], v1[1]); w[bj].w = pk2(v1[2], v1[3]); }
                if (gate) stage_store2<true>(tw, fr, fq, lane, w[0], w[1], gq + (size_t)(ai * 128 + m * 16) * DIN);
                else stage_store2<false>(tw, fr, fq, lane, w[0], w[1], gq + (size_t)(ai * 128 + m * 16) * DIN); }
    }
};
struct EpiBranch {
    static constexpr bool PERM = true, AFTER_DRAIN = false, KEEP = true;
    const bf16_t* P; bf16_t* MG; unsigned char* elds;
    __device__ __forceinline__ bool run(f32x4 (&acc)[2][2][4][2], const pg8::Unit& u, int wr, int wc, int fr, int fq) const {
        const int lane = fq * 16 + fr;
        bf16_t* tw = (bf16_t*)(elds + EPI_LDS_OFF + (wr * 4 + wc) * EPI_LDS_WAVE);
        const size_t rq = (size_t)(u.pm * 256 + wr * 64 + (lane >> 2)); const int cq = u.pn * 256 + wc * 32 + (lane & 3) * 8;
        const bf16_t* gq = P + rq * DIN + C_GATE + u.n * 1024 + cq;
        bf16_t* mq = MG + rq * DM + cq;
#pragma unroll
        for (int ai = 0; ai < 2; ++ai)
#pragma unroll
            for (int m = 0; m < 4; ++m) { const size_t ro = (size_t)(ai * 128 + m * 16);
                u32x4 gt[2], gn[2];
                stage_load2(tw, fr, fq, lane, gq + ro * DIN, gt[0], gt[1]);
                if (u.n < 2) stage_load2(tw, fr, fq, lane, gq + ro * DIN + 1024, gn[0], gn[1]);
                u32x4 w[2];
#pragma unroll
                for (int bj = 0; bj < 2; ++bj) {
                    float g[8]; g[0] = bflo(gt[bj].x); g[1] = bfhi(gt[bj].x); g[2] = bflo(gt[bj].y); g[3] = bfhi(gt[bj].y); g[4] = bflo(gt[bj].z); g[5] = bfhi(gt[bj].z); g[6] = bflo(gt[bj].w); g[7] = bfhi(gt[bj].w);
                    if (u.n > 0) {
#pragma unroll
                        for (int e = 0; e < 8; ++e) g[e] = fmaxf(g[e], 1e-6f);
                    }
                    if (u.n < 2) {
                        float h[8]; h[0] = bflo(gn[bj].x); h[1] = bfhi(gn[bj].x); h[2] = bflo(gn[bj].y); h[3] = bfhi(gn[bj].y); h[4] = bflo(gn[bj].z); h[5] = bfhi(gn[bj].z); h[6] = bflo(gn[bj].w); h[7] = bfhi(gn[bj].w);
#pragma unroll
                        for (int e = 0; e < 8; ++e) g[e] = g[e] * __builtin_amdgcn_rcpf(fmaxf(h[e], 1e-6f));
                    }
                    f32x4 a0 = acc[ai][bj][m][0], a1 = acc[ai][bj][m][1];
                    a0[0] *= g[0]; a0[1] *= g[1]; a0[2] *= g[2]; a0[3] *= g[3]; a1[0] *= g[4]; a1[1] *= g[5]; a1[2] *= g[6]; a1[3] *= g[7];
                    if (u.n < 2) { acc[ai][bj][m][0] = a0; acc[ai][bj][m][1] = a1; }
                    else { w[bj].x = pk2(a0[0], a0[1]); w[bj].y = pk2(a0[2], a0[3]); w[bj].z = pk2(a1[0], a1[1]); w[bj].w = pk2(a1[2], a1[3]); } }
                if (u.n == 2) stage_store2(tw, fr, fq, lane, w[0], w[1], mq + ro * DM); }
        return u.n == 2;
    }
};
struct BranchSched {
    int G, c;
    __device__ __forceinline__ bool next(int i, pg8::Unit& u) const {
        const int t = i / 3, n = i - 3 * t; const long L = (long)t * G + c; if (L >= 512) return false;
        pg8::tile_of((int)L, 128, 4, WGM_SMALL, u.pm, u.pn); u.n = n;
        const int colA = (n == 0) ? 0 : (n == 1 ? C_POOL : C_QC);
        u.aoff = ((size_t)u.pm * 256 * DIN + colA) * 2; u.boff = ((size_t)(n * 1024 + u.pn * 256) * 512) * 2; return true;
    }
    __device__ __forceinline__ void a_ready(const pg8::Unit&) const {}
    __device__ __forceinline__ void done(const pg8::Unit&) const {}
};
struct EpiUp {
    static constexpr bool PERM = true, AFTER_DRAIN = false, KEEP = false;
    bf16_t* O; bf16_t* HALO; unsigned char* elds;
    __device__ __forceinline__ void operator()(const f32x4 (&acc)[2][2][4][2], const pg8::Unit& u, int wr, int wc, int fr, int fq) const {
        const int col0 = u.pn * 256 + wc * 32 + 8 * fq, lane = fq * 16 + fr;
        bf16_t* tw = (bf16_t*)(elds + EPI_LDS_OFF + (wr * 4 + wc) * EPI_LDS_WAVE);
        bf16_t* gq = O + (size_t)(u.pm * 256 + wr * 64 + (lane >> 2)) * DUP + u.pn * 256 + wc * 32 + (lane & 3) * 8;
        const bool val = (u.pn < 11);
#pragma unroll
        for (int ai = 0; ai < 2; ++ai)
#pragma unroll
            for (int m = 0; m < 4; ++m) { u32x4 ww[2];
#pragma unroll
                for (int bj = 0; bj < 2; ++bj) { const f32x4 v0 = acc[ai][bj][m][0], v1 = acc[ai][bj][m][1];
                    u32x4 w; w.x = pk2(v0[0], v0[1]); w.y = pk2(v0[2], v0[3]); w.z = pk2(v1[0], v1[1]); w.w = pk2(v1[2], v1[3]);
                    ww[bj] = w;
                    if (val && (m & 1) == 0 && fr == 0)  *(u32x4*)(HALO + ((size_t)((u.pm * 8 + ai * 4 + wr * 2 + (m >> 1)) * 2 + 0)) * DFF + col0 + bj * 128) = w;
                    if (val && (m & 1) == 1 && fr == 15) *(u32x4*)(HALO + ((size_t)((u.pm * 8 + ai * 4 + wr * 2 + (m >> 1)) * 2 + 1)) * DFF + col0 + bj * 128) = w; }
                stage_store2(tw, fr, fq, lane, ww[0], ww[1], gq + (size_t)(ai * 128 + m * 16) * DUP); }
    }
};

struct Ctx {
    const float* in[18]; float* out; unsigned char* ws; unsigned char* lds; int G, wv;
};

__device__ __forceinline__ void transpose_item(const float* W, int K, int N, bf16_t* WT, float* scr, int item, int lane) {
    const int nblk = N / 32, kb = item / nblk, nb = item % nblk, k0 = 64 * kb, n0 = 32 * nb;
#pragma unroll 8
    for (int i = 0; i < 32; ++i) { const int kk = 2 * i + (lane >> 5); scr[kk * 33 + (lane & 31)] = __builtin_nontemporal_load(&W[(size_t)(k0 + kk) * N + n0 + (lane & 31)]); }
    asm volatile("s_waitcnt lgkmcnt(0)" ::: "memory");
    const int c = lane & 7;
#pragma unroll
    for (int j = 0; j < 4; ++j) { const int n = (lane >> 3) + 8 * j; const float* s = scr + (8 * c) * 33 + n;
        u32x4 o; o.x = pk2(s[0 * 33], s[1 * 33]); o.y = pk2(s[2 * 33], s[3 * 33]); o.z = pk2(s[4 * 33], s[5 * 33]); o.w = pk2(s[6 * 33], s[7 * 33]);
        *(u32x4*)(WT + (size_t)(n0 + n) * K + k0 + 8 * c) = o; }
    asm volatile("s_waitcnt lgkmcnt(0)" ::: "memory");
}
__device__ __forceinline__ void norm_row(const float* xrow, const float* g, bf16_t* orow, int lane) {
    const f32x4* xr = (const f32x4*)xrow + lane; const f32x4* gr = (const f32x4*)g + lane;
    f32x4 v[4]; float s = 0.f;
#pragma unroll
    for (int j = 0; j < 4; ++j) { v[j] = __builtin_nontemporal_load(&xr[64 * j]); s += (v[j].x * v[j].x + v[j].y * v[j].y) + (v[j].z * v[j].z + v[j].w * v[j].w); }
    const float rs = rsqrtf(wave_sum(s) * (1.f / DM) + EPS);
    u32x2* o8 = (u32x2*)orow + lane;
#pragma unroll
    for (int j = 0; j < 4; ++j) { const f32x4 gg = gr[64 * j]; u32x2 w; w.x = pk2(v[j].x * rs * gg.x, v[j].y * rs * gg.y); w.y = pk2(v[j].z * rs * gg.z, v[j].w * rs * gg.w); o8[64 * j] = w; }
}
template <int R>
__device__ __forceinline__ void resnorm_rows(const bf16_t* src, const float* xin, const float* gpost, float* xo, const float* gnext, bf16_t* xn, size_t rstride, int lane) {
    f32x4 v[R][4], xx[R][4]; float s[R];
#pragma unroll
    for (int r = 0; r < R; ++r) { const u32x2* sr = (const u32x2*)(src + r * rstride) + lane; const f32x4* xr = (const f32x4*)(xin + r * rstride) + lane; s[r] = 0.f;
#pragma unroll
        for (int j = 0; j < 4; ++j) { const u32x2 w = __builtin_nontemporal_load(&sr[64 * j]); xx[r][j] = __builtin_nontemporal_load(&xr[64 * j]); v[r][j] = (f32x4){bflo(w.x), bfhi(w.x), bflo(w.y), bfhi(w.y)}; } }
#pragma unroll
    for (int r = 0; r < R; ++r)
#pragma unroll
        for (int j = 0; j < 4; ++j) s[r] += (v[r][j].x * v[r][j].x + v[r][j].y * v[r][j].y) + (v[r][j].z * v[r][j].z + v[r][j].w * v[r][j].w);
    const f32x4* gp = (const f32x4*)gpost + lane;
    float s2[R];
#pragma unroll
    for (int r = 0; r < R; ++r) { const float rs = rsqrtf(wave_sum(s[r]) * (1.f / DM) + EPS); s2[r] = 0.f; f32x4* xw = (f32x4*)(xo + r * rstride) + lane;
#pragma unroll
        for (int j = 0; j < 4; ++j) { const f32x4 gg = gp[64 * j]; v[r][j] = xx[r][j] + v[r][j] * rs * gg; s2[r] += (v[r][j].x * v[r][j].x + v[r][j].y * v[r][j].y) + (v[r][j].z * v[r][j].z + v[r][j].w * v[r][j].w); __builtin_nontemporal_store(v[r][j], &xw[64 * j]); } }
    if (gnext) {
        const f32x4* gn = (const f32x4*)gnext + lane;
#pragma unroll
        for (int r = 0; r < R; ++r) { const float rs2 = rsqrtf(wave_sum(s2[r]) * (1.f / DM) + EPS); u32x2* o8 = (u32x2*)(xn + r * rstride) + lane;
#pragma unroll
            for (int j = 0; j < 4; ++j) { const f32x4 gg = gn[64 * j]; u32x2 w; w.x = pk2(v[r][j].x * rs2 * gg.x, v[r][j].y * rs2 * gg.y); w.y = pk2(v[r][j].z * rs2 * gg.z, v[r][j].w * rs2 * gg.w); o8[64 * j] = w; } }
    }
}
__device__ __forceinline__ void p0_prologue(const Ctx& C) {
    int tid_ = TID_NOW(C.wv); asm volatile("" : "+v"(tid_)); const int tid = tid_, lane = tid & 63, wave = __builtin_amdgcn_readfirstlane(tid >> 6); (void)tid; (void)lane; (void)wave;
    bf16_t* Wb = (bf16_t*)(C.ws + WS_W);
    float* scr = (float*)(C.lds + wave * 16384);
    const int gw = blockIdx.x * 8 + wave, NGW = C.G * 8;
    constexpr int I_IN = 16 * 184, I_BR = 8 * 32, I_OUT = 16 * 32, I_UP = 16 * 176, I_DN = 44 * 32, I_L = I_IN + 3 * I_BR + I_OUT + I_UP + I_DN;
    for (int it = gw; it < 2 * I_L; it += NGW) {
        const int l = it / I_L; int r = it - l * I_L;
        if (r < I_IN) { transpose_item(C.in[5] + (size_t)l * 1024 * DIN, 1024, DIN, Wb + OW_IN + (size_t)l * DIN * 1024, scr, r, lane); continue; } r -= I_IN;
        if (r < 3 * I_BR) { const int n = r / I_BR; transpose_item(C.in[12] + (size_t)(l * 3 + n) * 512 * 1024, 512, 1024, Wb + OW_BR + (size_t)(l * 3 + n) * 1024 * 512, scr, r - n * I_BR, lane); continue; } r -= 3 * I_BR;
        if (r < I_OUT) { transpose_item(C.in[13] + (size_t)l * 1024 * 1024, 1024, 1024, Wb + OW_OUT + (size_t)l * 1024 * 1024, scr, r, lane); continue; } r -= I_OUT;
        if (r < I_UP) { transpose_item(C.in[14] + (size_t)l * 1024 * DUP, 1024, DUP, Wb + OW_UP + (size_t)l * DUP * 1024, scr, r, lane); continue; } r -= I_UP;
        transpose_item(C.in[17] + (size_t)l * DFF * 1024, DFF, 1024, Wb + OW_DN + (size_t)l * 1024 * DFF, scr, r, lane);
    }
    for (int idx = blockIdx.x * 512 + tid; idx < 2 * 512 * 512; idx += C.G * 512) {
        const int l = idx >> 18, n = (idx >> 9) & 511, k = idx & 511, g = n >> 7;
        float v = 0.f;
        if ((k >> 7) == g) v = C.in[9][((size_t)(l * 4 + g) * 128 + (k & 127)) * 128 + (n & 127)] * C.in[10][l * 512 + n];
        Wb[OW_POOL + idx] = (bf16_t)(pk2(v, 0.f) & 0xffffu);
    }
    bf16_t* XN = (bf16_t*)(C.ws + WS_XN);
    for (int m = gw; m < NTOK; m += NGW) norm_row(C.in[0] + (size_t)m * DM, C.in[1], XN + (size_t)m * DM, lane);
}

__device__ __forceinline__ void p2_prep(const Ctx& C, int l) {
    bf16_t* P = (bf16_t*)(C.ws + WS_BIG);
    bf16_t* DIFF = (bf16_t*)(C.ws + WS_XN);
    bf16_t* VCT = (bf16_t*)(C.ws + WS_XN + 32 * MiB);
    bf16_t* VAT = (bf16_t*)(C.ws + WS_VAT);
    const float* gk = C.in[8] + l * 64;
    int tid_ = TID_NOW(C.wv); asm volatile("" : "+v"(tid_)); const int tid = tid_, lane = tid & 63, wave = __builtin_amdgcn_readfirstlane(tid >> 6); (void)tid;
    bf16_t* TA = (bf16_t*)(C.lds + wave * 10752);
    bf16_t* TC = TA + 8 * 136;
    int bx = blockIdx.x; asm volatile("" : "+s"(bx));
    const int gw = bx * 8 + wave, NGW = C.G * 8;
    const int g = lane >> 4, hw = 1 << g;
    const u32x4 zero4 = {0u, 0u, 0u, 0u};
    for (int cq = gw; cq < NTOK / 8; cq += NGW) {
        const int ck = cq;
        const int tok0 = ck * 8, b = tok0 >> 11, s0 = tok0 & 2047, r = s0 >> 6, c8 = (s0 >> 3) & 7;
        {
            const int j16 = lane & 15, rg = lane >> 4;
            u32x2 raw[4];
#pragma unroll
            for (int ps = 0; ps < 4; ++ps) { const int rw = ps * 4 + rg, tok = tok0 + (rw >> 1); raw[ps] = *(const u32x2*)(P + (size_t)tok * DIN + C_KA + (rw & 1) * 64 + 4 * j16); }
            const f32x4 gk4 = *(const f32x4*)(gk + 4 * j16);
            const bool hi16 = (j16 & 4) != 0;
#pragma unroll
            for (int ps = 0; ps < 4; ++ps) {
                const int rw = ps * 4 + rg, tok = tok0 + (rw >> 1), t = tok & 2047;
                float x[4] = {bflo(raw[ps].x), bfhi(raw[ps].x), bflo(raw[ps].y), bfhi(raw[ps].y)};
                float ss = x[0] * x[0] + x[1] * x[1] + x[2] * x[2] + x[3] * x[3];
                ss += __shfl_xor(ss, 1); ss += __shfl_xor(ss, 2); ss += __shfl_xor(ss, 4); ss += __shfl_xor(ss, 8);
                const float rs = rsqrtf(ss * (1.f / 64.f) + EPS);
                const float pos = (float)((j16 < 8) ? (t >> 6) : (t & 63));
                float o[4];
#pragma unroll
                for (int e = 0; e < 4; ++e) {
                    const int fi = (4 * j16 + e) & 15;
                    const float ang = pos * __builtin_amdgcn_exp2f(-13.287712379549449f * (float)fi * (1.f / 16.f));
                    const float y = x[e] * rs * gk4[e];
                    const float prt = __shfl_xor(y, 4);
                    o[e] = y * __cosf(ang) + (hi16 ? prt : -prt) * __sinf(ang);
                }
                u32x2 ov; ov.x = pk2(o[0], o[1]); ov.y = pk2(o[2], o[3]);
                *(u32x2*)(P + (size_t)tok * DIN + C_KA + (rw & 1) * 64 + 4 * j16) = ov;
            }
        }
        u32x4 vc[8], va[2], pr[23];
#pragma unroll
        for (int k = 0; k < 8; ++k) vc[k] = __builtin_nontemporal_load((const u32x4*)(P + (size_t)(tok0 + k) * DIN + C_VC + 8 * lane));
#pragma unroll
        for (int j = 0; j < 2; ++j) va[j] = __builtin_nontemporal_load((const u32x4*)(P + (size_t)(tok0 + 4 * j + (lane >> 4)) * DIN + C_VA + 8 * (lane & 15)));
        const bf16_t* pbase = P + (size_t)(b * SEQ) * DIN + C_POOL + 8 * lane;
#pragma unroll
        for (int o = 0; o < 23; ++o) { const int row = s0 + o - 8; const bool need = (o - 8 >= -hw) && (o - 8 < 8 + hw) && row >= 0 && row < SEQ;
            pr[o] = zero4; if (need) pr[o] = *(const u32x4*)(pbase + (size_t)row * DIN); }
#pragma unroll
        for (int k = 0; k < 8; ++k) *(u32x4*)(TC + k * 520 + 8 * lane) = vc[k];
#pragma unroll
        for (int j = 0; j < 2; ++j) *(u32x4*)(TA + (4 * j + (lane >> 4)) * 136 + 8 * (lane & 15)) = va[j];
#pragma unroll
        for (int k = 0; k < 8; ++k) {
            float w2[8], w4[8], w8[8], w16[8];
#define ACC_ROW(dst, idx) do { float f_[8]; u32x4 t_ = pr[idx]; asm volatile("" : "+v"(t_));     unpack8(t_, f_); _Pragma("unroll") for (int e = 0; e < 8; ++e) dst[e] += f_[e]; } while (0)
#pragma unroll
            for (int e = 0; e < 8; ++e) w2[e] = 0.f;
            ACC_ROW(w2, k + 7); ACC_ROW(w2, k + 8);
#pragma unroll
            for (int e = 0; e < 8; ++e) w4[e] = w2[e];
            ACC_ROW(w4, k + 6); ACC_ROW(w4, k + 9);
#pragma unroll
            for (int e = 0; e < 8; ++e) w8[e] = w4[e];
            ACC_ROW(w8, k + 4); ACC_ROW(w8, k + 5); ACC_ROW(w8, k + 10); ACC_ROW(w8, k + 11);
#pragma unroll
            for (int e = 0; e < 8; ++e) w16[e] = w8[e];
            ACC_ROW(w16, k + 0); ACC_ROW(w16, k + 1); ACC_ROW(w16, k + 2); ACC_ROW(w16, k + 3); ACC_ROW(w16, k + 12); ACC_ROW(w16, k + 13); ACC_ROW(w16, k + 14); ACC_ROW(w16, k + 15);
#undef ACC_ROW
            const int t = s0 + k; int lo = t - hw; if (lo < 0) lo = 0; int hi = t + hw; if (hi > SEQ) hi = SEQ;
            const float inv = 1.f / (float)(hi - lo);
            float self[8]; unpack8(pr[k + 8], self);
            float o[8];
#pragma unroll
            for (int e = 0; e < 8; ++e) { const float sm = (g == 0) ? w2[e] : (g == 1) ? w4[e] : (g == 2) ? w8[e] : w16[e]; o[e] = sm * inv - self[e]; }
            u32x4 ov; ov.x = pk2(o[0], o[1]); ov.y = pk2(o[2], o[3]); ov.z = pk2(o[4], o[5]); ov.w = pk2(o[6], o[7]);
            *(u32x4*)(DIFF + (size_t)(tok0 + k) * 512 + 8 * lane) = ov;
        }
#pragma unroll
        for (int kk = 0; kk < 2; ++kk) { const int rw = lane + 64 * kk; unsigned pkd[4];
#pragma unroll
            for (int k = 0; k < 4; ++k) pkd[k] = (unsigned)TA[(2 * k) * 136 + rw] | ((unsigned)TA[(2 * k + 1) * 136 + rw] << 16);
            *(u32x4*)(VAT + ((size_t)(b * 128 + rw)) * SEQ + s0) = (u32x4){pkd[0], pkd[1], pkd[2], pkd[3]}; }
#pragma unroll
        for (int kk = 0; kk < 8; ++kk) { const int cc = lane + 64 * kk; unsigned pkd[4];
#pragma unroll
            for (int k = 0; k < 4; ++k) pkd[k] = (unsigned)TC[(2 * k) * 520 + cc] | ((unsigned)TC[(2 * k + 1) * 520 + cc] << 16);
            *(u32x4*)(VCT + ((size_t)((((b * 8 + kk) * 32 + r) * 8 + c8) * 64 + lane)) * 8) = (u32x4){pkd[0], pkd[1], pkd[2], pkd[3]}; }
    }
}

__device__ __forceinline__ void attn_qprep(const Ctx& C, int l, const bf16_t* Qrow, int tq, int hi_in, bf16_t* qdst) {
    int hi = hi_in; asm volatile("" : "+v"(hi));
    float xq[4][8]; float ss = 0.f;
#pragma unroll
    for (int ks = 0; ks < 4; ++ks) { const u32x4 rq = __builtin_nontemporal_load((const u32x4*)(Qrow + 16 * ks + 8 * hi));
        xq[ks][0] = bflo(rq.x); xq[ks][1] = bfhi(rq.x); xq[ks][2] = bflo(rq.y); xq[ks][3] = bfhi(rq.y); xq[ks][4] = bflo(rq.z); xq[ks][5] = bfhi(rq.z); xq[ks][6] = bflo(rq.w); xq[ks][7] = bfhi(rq.w);
#pragma unroll
        for (int e = 0; e < 8; ++e) ss += xq[ks][e] * xq[ks][e]; }
    ss += __shfl_xor(ss, 32);
    const float rs = rsqrtf(ss * (1.f / 64.f) + EPS) * (0.125f * LOG2E);
    const float prow = (float)(tq >> 6), pcol = (float)(tq & 63);
    const float* gq = C.in[7] + l * 64 + 8 * hi;
    float oq[4][8];
#pragma unroll
    for (int e = 0; e < 8; ++e) {
        const float fr_ = __builtin_amdgcn_exp2f(-13.287712379549449f * (float)(8 * hi + e) * (1.f / 16.f));
        const float ar = prow * fr_, ac = pcol * fr_;
        const float cr = __cosf(ar), sr_ = __sinf(ar), cc = __cosf(ac), sc_ = __sinf(ac);
        const float y0 = xq[0][e] * rs * gq[e], y1 = xq[1][e] * rs * gq[16 + e], y2 = xq[2][e] * rs * gq[32 + e], y3 = xq[3][e] * rs * gq[48 + e];
        oq[0][e] = y0 * cr - y1 * sr_; oq[1][e] = y0 * sr_ + y1 * cr; oq[2][e] = y2 * cc - y3 * sc_; oq[3][e] = y2 * sc_ + y3 * cc;
    }
#pragma unroll
    for (int ks = 0; ks < 4; ++ks) { u32x4 a; a.x = pk2(oq[ks][0], oq[ks][1]); a.y = pk2(oq[ks][2], oq[ks][3]); a.z = pk2(oq[ks][4], oq[ks][5]); a.w = pk2(oq[ks][6], oq[ks][7]); *(u32x4*)(qdst + ks * 512) = a; }
}
__device__ __forceinline__ void attn_softmax_pack(f32x16& S0, f32x16& S1, float& lsum, bf16x8 (&p)[4]) {
    float ls = 0.f;
#pragma unroll
    for (int i = 0; i < 16; ++i) { S0[i] = __builtin_amdgcn_exp2f(S0[i]); S1[i] = __builtin_amdgcn_exp2f(S1[i]); ls += S0[i] + S1[i]; }
    lsum += ls;
    { u32x4 a; a.x = pk2(S0[0], S0[1]); a.y = pk2(S0[2], S0[3]); a.z = pk2(S0[4], S0[5]); a.w = pk2(S0[6], S0[7]); p[0] = __builtin_bit_cast(bf16x8, a); }
    { u32x4 a; a.x = pk2(S0[8], S0[9]); a.y = pk2(S0[10], S0[11]); a.z = pk2(S0[12], S0[13]); a.w = pk2(S0[14], S0[15]); p[1] = __builtin_bit_cast(bf16x8, a); }
    { u32x4 a; a.x = pk2(S1[0], S1[1]); a.y = pk2(S1[2], S1[3]); a.z = pk2(S1[4], S1[5]); a.w = pk2(S1[6], S1[7]); p[2] = __builtin_bit_cast(bf16x8, a); }
    { u32x4 a; a.x = pk2(S1[8], S1[9]); a.y = pk2(S1[10], S1[11]); a.z = pk2(S1[12], S1[13]); a.w = pk2(S1[14], S1[15]); p[3] = __builtin_bit_cast(bf16x8, a); }
}
__device__ __forceinline__ void attn_store(bf16_t* Orow, const f32x16& O0, const f32x16& O1, float lsum, int hi) {
    const float inv = 1.f / (lsum + __shfl_xor(lsum, 32));
#pragma unroll
    for (int i4 = 0; i4 < 4; ++i4) {
        u32x2 a; a.x = pk2(O0[4 * i4] * inv, O0[4 * i4 + 1] * inv); a.y = pk2(O0[4 * i4 + 2] * inv, O0[4 * i4 + 3] * inv);
        *(u32x2*)(Orow + 8 * i4 + 4 * hi) = a;
        u32x2 c; c.x = pk2(O1[4 * i4] * inv, O1[4 * i4 + 1] * inv); c.y = pk2(O1[4 * i4 + 2] * inv, O1[4 * i4 + 3] * inv);
        *(u32x2*)(Orow + 32 + 8 * i4 + 4 * hi) = c;
    }
}
__device__ __forceinline__ void p3_attn(const Ctx& C, int l, int dummy) {
    bf16_t* P = (bf16_t*)(C.ws + WS_BIG);
    const bf16_t* VAT = (const bf16_t*)(C.ws + WS_VAT);
    int tid_ = TID_NOW(C.wv); asm volatile("" : "+v"(tid_)); const int tid = tid_, lane = tid & 63, wave = __builtin_amdgcn_readfirstlane(tid >> 6);
    const int w = wave, hi = lane >> 5, l32 = lane & 31;
    const float nMb = -8.f * LOG2E * wave_max(fabsf(C.in[7][l * 64 + lane])) * wave_max(fabsf(C.in[8][l * 64 + lane]));
    const int pm = (l32 & ~12) | ((l32 & 4) << 1) | ((l32 & 8) >> 1);
    bf16_t* Ks = (bf16_t*)C.lds;
    bf16_t* Vs = Ks + 2 * 64 * 72;
    const int sr = tid >> 3, sc = tid & 7;
    bf16_t* Qs = (bf16_t*)(C.lds + 36864) + w * 4096 + lane * 8;
    for (int u = blockIdx.x; u < 512; u += C.G) {
        int b, h, qb, kvh;
        if (C.G == 256) { const int cx = blockIdx.x & 7, cj = blockIdx.x >> 3, pr = 4 * cx + (cj >> 3); b = pr >> 1; kvh = pr & 1; qb = (cj & 7) >> 1; h = 4 * kvh + 2 * (cj & 1) + (u >> 8); }
        else { b = u >> 5; h = (u >> 2) & 7; qb = u & 3; kvh = h >> 2; }
        const int tqA = qb * 512 + w * 64 + l32;
        bf16_t* QrowA = P + (size_t)(b * SEQ + tqA) * DIN + h * 64;
        bf16_t* QrowB = QrowA + (size_t)32 * DIN;
        attn_qprep(C, l, QrowA, tqA, hi, Qs);
        attn_qprep(C, l, QrowB, tqA + 32, hi, Qs + 2048);
        const bf16_t* Kg = P + (size_t)(b * SEQ + sr) * DIN + C_KA + kvh * 64 + 8 * sc;
        const bf16_t* Vg = VAT + (size_t)((b * 2 + kvh) * 64 + sr) * SEQ + 8 * sc;
        f32x16 OA0, OA1, OB0, OB1;
#pragma unroll
        for (int i = 0; i < 16; ++i) { OA0[i] = 0.f; OA1[i] = 0.f; OB0[i] = 0.f; OB1[i] = 0.f; }
        float lsA = 0.f, lsB = 0.f;
        u32x4 kreg = *(const u32x4*)Kg, vreg = *(const u32x4*)Vg;
        __syncthreads();
        *(u32x4*)(Ks + sr * 72 + 8 * sc) = kreg; *(u32x4*)(Vs + sr * 72 + 8 * sc) = vreg;
        __syncthreads();
        for (int t = 0; t < 32; ++t) {
            const int buf = t & 1;
            if (t + 1 < 32) { kreg = *(const u32x4*)(Kg + (size_t)(t + 1) * 64 * DIN); vreg = *(const u32x4*)(Vg + (t + 1) * 64); }
            const bf16_t* Kb = Ks + buf * 64 * 72; const bf16_t* Vb = Vs + buf * 64 * 72;
            bf16x8 pA[4], pB[4];
            {   f32x16 S0, S1;
#pragma unroll
                for (int i = 0; i < 16; ++i) { S0[i] = nMb; S1[i] = nMb; }
#pragma unroll
                for (int ks = 0; ks < 4; ++ks) {
                    const bf16x8 k0 = *(const bf16x8*)(Kb + pm * 72 + 16 * ks + 8 * hi);
                    const bf16x8 k1 = *(const bf16x8*)(Kb + (32 + pm) * 72 + 16 * ks + 8 * hi);
                    const bf16x8 qv = *(const bf16x8*)(Qs + ks * 512);
                    S0 = __builtin_amdgcn_mfma_f32_32x32x16_bf16(k0, qv, S0, 0, 0, 0);
                    S1 = __builtin_amdgcn_mfma_f32_32x32x16_bf16(k1, qv, S1, 0, 0, 0);
                }
                attn_softmax_pack(S0, S1, lsA, pA);
            }
            {   f32x16 S0, S1;
#pragma unroll
                for (int i = 0; i < 16; ++i) { S0[i] = nMb; S1[i] = nMb; }
#pragma unroll
                for (int ks = 0; ks < 4; ++ks) {
                    const bf16x8 k0 = *(const bf16x8*)(Kb + pm * 72 + 16 * ks + 8 * hi);
                    const bf16x8 k1 = *(const bf16x8*)(Kb + (32 + pm) * 72 + 16 * ks + 8 * hi);
                    const bf16x8 qv = *(const bf16x8*)(Qs + 2048 + ks * 512);
                    S0 = __builtin_amdgcn_mfma_f32_32x32x16_bf16(k0, qv, S0, 0, 0, 0);
                    S1 = __builtin_amdgcn_mfma_f32_32x32x16_bf16(k1, qv, S1, 0, 0, 0);
                }
                attn_softmax_pack(S0, S1, lsB, pB);
            }
#pragma unroll
            for (int jj = 0; jj < 4; ++jj) {
                const bf16x8 v0 = *(const bf16x8*)(Vb + l32 * 72 + 16 * jj + 8 * hi);
                const bf16x8 v1 = *(const bf16x8*)(Vb + (32 + l32) * 72 + 16 * jj + 8 * hi);
                OA0 = __builtin_amdgcn_mfma_f32_32x32x16_bf16(v0, pA[jj], OA0, 0, 0, 0);
                OA1 = __builtin_amdgcn_mfma_f32_32x32x16_bf16(v1, pA[jj], OA1, 0, 0, 0);
                OB0 = __builtin_amdgcn_mfma_f32_32x32x16_bf16(v0, pB[jj], OB0, 0, 0, 0);
                OB1 = __builtin_amdgcn_mfma_f32_32x32x16_bf16(v1, pB[jj], OB1, 0, 0, 0);
            }
            if (t + 1 < 32) { *(u32x4*)(Ks + (buf ^ 1) * 64 * 72 + sr * 72 + 8 * sc) = kreg; *(u32x4*)(Vs + (buf ^ 1) * 64 * 72 + sr * 72 + 8 * sc) = vreg; }
            __syncthreads();
        }
        attn_store(QrowA, OA0, OA1, lsA, hi);
        attn_store(QrowB, OB0, OB1, lsB, hi);
    }
}

__device__ __forceinline__ void p3_natten(const Ctx& C, int l, int dummy) {
    bf16_t* P = (bf16_t*)(C.ws + WS_BIG);
    const bf16_t* VCT = (const bf16_t*)(C.ws + WS_XN + 32 * MiB);
    int tid_ = TID_NOW(C.wv); asm volatile("" : "+v"(tid_)); const int tid = tid_, lane = tid & 63, wave = __builtin_amdgcn_readfirstlane(tid >> 6); (void)tid;
    const int h = wave, q = lane & 15, Qr = lane >> 4;
    bf16_t* kt = (bf16_t*)(C.lds + h * 4608);
    bf16_t* vt = (bf16_t*)(C.lds + 36864 + h * 5120);
    float* rp = (float*)(C.lds + 81920) + h * 960;
    { const float* rpb = C.in[11] + (size_t)(l * 8 + h) * 15 * 31;
#pragma unroll
      for (int i = 0; i < 15; ++i) { const int dc = lane - 16; rp[i * 64 + lane] = (dc >= 0 && dc < 31) ? rpb[i * 31 + dc] : 0.f; } }
    for (int u = blockIdx.x; u < 2048; u += C.G) {
        int b, r, cgp;
        if (C.G == 256) { const int cx = blockIdx.x & 7, idx = (blockIdx.x >> 3) + 32 * (u >> 8); b = 2 * cx + (idx >> 7); r = (idx >> 2) & 31; cgp = idx & 3; }
        else { b = u >> 7; r = (u >> 2) & 31; cgp = u & 3; }
        const int c0 = cgp * 16;
        int kc0 = c0 - 8; kc0 = kc0 < 0 ? 0 : (kc0 > 32 ? 32 : kc0);
        int rs = r - 4; rs = rs < 0 ? 0 : (rs > 24 ? 24 : rs);
        const int c = c0 + q; int cs = c - 8; cs = cs < 0 ? 0 : (cs > 48 ? 48 : cs);
        bf16_t* qrow = P + (size_t)(b * SEQ + r * 64 + c) * DIN + C_QC + h * 64;
        bf16_t* qio = P + (size_t)(b * SEQ + r * 64 + c0 + (lane >> 3)) * DIN + C_QC + h * 64 + 8 * (lane & 7);
        { const u32x4 qa = __builtin_nontemporal_load((const u32x4*)qio), qb2 = __builtin_nontemporal_load((const u32x4*)(qio + (size_t)8 * DIN));
          *(u32x4*)(vt + (lane >> 3) * 72 + 8 * (lane & 7)) = qa; *(u32x4*)(vt + (8 + (lane >> 3)) * 72 + 8 * (lane & 7)) = qb2; }
        const bf16x8 q0 = *(const bf16x8*)(vt + q * 72 + 8 * Qr), q1 = *(const bf16x8*)(vt + q * 72 + 32 + 8 * Qr);
        const int kcolA = 8 * (q >> 2) + (q & 3);
        const bf16_t* kg = P + (size_t)(b * SEQ + rs * 64 + kc0 + (lane >> 3)) * DIN + C_KC + h * 64 + 8 * (lane & 7);
        u32x4 kr[8][4];
#pragma unroll
        for (int rr = 0; rr < 8; ++rr)
#pragma unroll
            for (int j = 0; j < 4; ++j) kr[rr][j] = *(const u32x4*)(kg + (size_t)(rr * 64 + 8 * j) * DIN);
        f32x4 S[8][2];
#pragma unroll
        for (int rr = 0; rr < 8; ++rr) {
#pragma unroll
            for (int j = 0; j < 4; ++j) *(u32x4*)(kt + (8 * j + (lane >> 3)) * 72 + 8 * (lane & 7)) = kr[rr][j];
#pragma unroll
            for (int a = 0; a < 2; ++a) {
                const bf16x8 k0 = *(const bf16x8*)(kt + (kcolA + 4 * a) * 72 + 8 * Qr), k1 = *(const bf16x8*)(kt + (kcolA + 4 * a) * 72 + 32 + 8 * Qr);
                f32x4 sx = {0.f, 0.f, 0.f, 0.f};
                sx = __builtin_amdgcn_mfma_f32_16x16x32_bf16(k0, q0, sx, 0, 0, 0);
                sx = __builtin_amdgcn_mfma_f32_16x16x32_bf16(k1, q1, sx, 0, 0, 0);
                S[rr][a] = sx;
            }
        }
        const bf16_t* vg = VCT + ((size_t)(((b * 8 + h) * 32 + rs) * 8 + (kc0 >> 3) + Qr) * 64 + q) * 8;
        bf16x8 vf[8][4];
#pragma unroll
        for (int rr = 0; rr < 8; ++rr)
#pragma unroll
            for (int d = 0; d < 4; ++d) vf[rr][d] = *(const bf16x8*)(vg + (size_t)rr * 4096 + d * 128);
        float mx = -3.0e38f;
        const int kcb = kc0 + 8 * Qr;
        bool okj[8];
#pragma unroll
        for (int j = 0; j < 8; ++j) okj[j] = (unsigned)(kcb + j - cs) < 16u;
        const float* rpl = rp + (rs - r + 7) * 64 + 16 + (kcb - c + 15);
#pragma unroll
        for (int rr = 0; rr < 8; ++rr) {
            float bia[8];
#pragma unroll
            for (int j = 0; j < 8; ++j) bia[j] = rpl[rr * 64 + j];
#pragma unroll
            for (int j = 0; j < 8; ++j) asm volatile("" : "+v"(bia[j]));
#pragma unroll
            for (int a = 0; a < 2; ++a)
#pragma unroll
                for (int i = 0; i < 4; ++i) {
                    const float sv = okj[4 * a + i] ? (S[rr][a][i] * 0.125f + bia[4 * a + i]) : -3.0e38f;
                    S[rr][a][i] = sv; mx = fmaxf(mx, sv);
                } }
        mx = fmaxf(mx, __shfl_xor(mx, 16)); mx = fmaxf(mx, __shfl_xor(mx, 32));
        float sum = 0.f;
#pragma unroll
        for (int rr = 0; rr < 8; ++rr)
#pragma unroll
            for (int a = 0; a < 2; ++a)
#pragma unroll
                for (int i = 0; i < 4; ++i) { const float pv = __builtin_amdgcn_exp2f((S[rr][a][i] - mx) * LOG2E); S[rr][a][i] = pv; sum += pv; }
        sum += __shfl_xor(sum, 16); sum += __shfl_xor(sum, 32);
        const float inv = 1.f / sum;
        f32x4 O[4];
#pragma unroll
        for (int d = 0; d < 4; ++d) O[d] = (f32x4){0.f, 0.f, 0.f, 0.f};
#pragma unroll
        for (int rr = 0; rr < 8; ++rr) {
            u32x4 pa; pa.x = pk2(S[rr][0][0], S[rr][0][1]); pa.y = pk2(S[rr][0][2], S[rr][0][3]); pa.z = pk2(S[rr][1][0], S[rr][1][1]); pa.w = pk2(S[rr][1][2], S[rr][1][3]);
            const bf16x8 pb = __builtin_bit_cast(bf16x8, pa);
#pragma unroll
            for (int d = 0; d < 4; ++d) O[d] = __builtin_amdgcn_mfma_f32_16x16x32_bf16(vf[rr][d], pb, O[d], 0, 0, 0);
        }
#pragma unroll
        for (int d = 0; d < 4; ++d) { u32x2 o; o.x = pk2(O[d][0] * inv, O[d][1] * inv); o.y = pk2(O[d][2] * inv, O[d][3] * inv); *(u32x2*)(vt + q * 72 + 16 * d + 4 * Qr) = o; }
        { const u32x4 oa = *(const u32x4*)(vt + (lane >> 3) * 72 + 8 * (lane & 7)), ob = *(const u32x4*)(vt + (8 + (lane >> 3)) * 72 + 8 * (lane & 7));
          *(u32x4*)qio = oa; *(u32x4*)(qio + (size_t)8 * DIN) = ob; }
    }
}

__device__ __forceinline__ void unpack8(const u32x4 v, float* f) { f[0] = bflo(v.x); f[1] = bfhi(v.x); f[2] = bflo(v.y); f[3] = bfhi(v.y); f[4] = bflo(v.z); f[5] = bfhi(v.z); f[6] = bflo(v.w); f[7] = bfhi(v.w); }
__device__ __forceinline__ void p8_convact(const Ctx& C, int l) {
    bf16_t* UP = (bf16_t*)(C.ws + WS_BIG);
    const bf16_t* HALO = (const bf16_t*)(C.ws + WS_VAT);
    const float* cw = C.in[15] + (size_t)l * 3 * DUP; const float* cb = C.in[16] + (size_t)l * DUP;
    int tid_ = TID_NOW(C.wv); asm volatile("" : "+v"(tid_)); const int tid = tid_, lane = tid & 63, wave = __builtin_amdgcn_readfirstlane(tid >> 6); (void)tid; (void)lane; (void)wave;
    const u32x4 zero = {0u, 0u, 0u, 0u};
    for (int it = blockIdx.x * 512 + tid; it < 1024 * 352; it += C.G * 512) {
        const int chq = it / 352, ct = it - chq * 352, ch = 1023 - chq, f = 8 * ct, row0 = ch * 32;
        float w0v[8], w1v[8], w2v[8], bvv[8], w0g[8], w1g[8], w2g[8], bgg[8];
#pragma unroll
        for (int e = 0; e < 8; ++e) { w0v[e] = cw[f + e]; w1v[e] = cw[DUP + f + e]; w2v[e] = cw[2 * DUP + f + e]; bvv[e] = cb[f + e];
            w0g[e] = cw[DFF + f + e]; w1g[e] = cw[DUP + DFF + f + e]; w2g[e] = cw[2 * DUP + DFF + f + e]; bgg[e] = cb[DFF + f + e]; }
        bf16_t* vp = UP + (size_t)row0 * DUP + f; const bf16_t* gp = vp + DFF;
        const bool first = (row0 & 2047) == 0, last = ((row0 + 32) & 2047) == 0;
        u32x4 pv = first ? zero : *(const u32x4*)(HALO + (size_t)((ch - 1) * 2 + 1) * DFF + f);
        u32x4 pg = first ? zero : *(const u32x4*)(gp - DUP);
        u32x4 cv = *(const u32x4*)vp, cgt = *(const u32x4*)gp;
        for (int r4 = 0; r4 < 32; r4 += 4) {
            u32x4 nv[4], ng[4];
#pragma unroll
            for (int k = 0; k < 4; ++k) {
                const int r = r4 + k + 1;
                if (r < 32) { nv[k] = __builtin_nontemporal_load((const u32x4*)(vp + (size_t)r * DUP)); ng[k] = __builtin_nontemporal_load((const u32x4*)(gp + (size_t)r * DUP)); }
                else { nv[k] = last ? zero : *(const u32x4*)(HALO + (size_t)((ch + 1) * 2) * DFF + f); ng[k] = last ? zero : *(const u32x4*)(gp + (size_t)32 * DUP); }
            }
#pragma unroll
            for (int k = 0; k < 4; ++k) {
                float a[8], bq[8], c[8], ga[8], gb[8], gc[8];
                unpack8(pv, a); unpack8(cv, bq); unpack8(nv[k], c); unpack8(pg, ga); unpack8(cgt, gb); unpack8(ng[k], gc);
                float o[8];
#pragma unroll
                for (int e = 0; e < 8; ++e) {
                    const float val = a[e] * w0v[e] + bq[e] * w1v[e] + c[e] * w2v[e] + bvv[e];
                    const float x = ga[e] * w0g[e] + gb[e] * w1g[e] + gc[e] * w2g[e] + bgg[e];
                    const float t2 = 1.5957691216057308f * (x + 0.044715f * x * x * x);
                    const float ge = x * __builtin_amdgcn_rcpf(1.f + __expf(-t2));
                    o[e] = ge * val;
                }
                u32x4 ov; ov.x = pk2(o[0], o[1]); ov.y = pk2(o[2], o[3]); ov.z = pk2(o[4], o[5]); ov.w = pk2(o[6], o[7]);
                *(u32x4*)(vp + (size_t)(r4 + k) * DUP) = ov;
                pv = cv; pg = cgt; cv = nv[k]; cgt = ng[k];
            }
        }
    }
}

#define XB_TMO      128
#define XB_XCNT(j)  (256  + 64 * (j))
#define XB_XSUB(j)  (1280 + 64 * (j))
#define XB_XGEN(j)  (2304 + 64 * (j))
#define XB_TOP      3328
#define XB_TOPGEN   3392
#define XCD_BAR_WORDS 3456
#define XB_SPIN_CAP (1u << 18)

__device__ __forceinline__ unsigned xb_ld(unsigned* p)              { return __hip_atomic_load(p, __ATOMIC_RELAXED, __HIP_MEMORY_SCOPE_AGENT); }
__device__ __forceinline__ unsigned xb_add(unsigned* p, unsigned v) { return __hip_atomic_fetch_add(p, v, __ATOMIC_RELAXED, __HIP_MEMORY_SCOPE_AGENT); }
__device__ __forceinline__ unsigned xb_xcc_id() { return (unsigned)__builtin_amdgcn_s_getreg((3 << 11) | 20) & 0xFu; }
#define XB_SPIN(cond, bar) do { unsigned _sp = 0; while (cond) { __builtin_amdgcn_s_sleep(1); \
    if ((++_sp & 255u) == 0u) { if (xb_ld(&(bar)[XB_TMO])) break; if (_sp > XB_SPIN_CAP) { atomicAdd(&(bar)[XB_TMO], 1u); break; } } } } while (0)

struct XcdBarrier {
    unsigned* bar; unsigned x; int wv;
    volatile LAS unsigned* st;
};

__device__ __forceinline__ XcdBarrier xcd_barrier_post(unsigned* bar, volatile LAS unsigned* st) {
    XcdBarrier b; b.bar = bar; b.x = xb_xcc_id(); b.st = st; b.wv = 0;
    if (threadIdx.x == 0) (void)xb_add(&bar[XB_XCNT(b.x)], 1u);
    return b;
}
__device__ __forceinline__ void xcd_barrier_complete(unsigned* bar, unsigned x, unsigned& nloc, unsigned& nx) {
    const unsigned G = gridDim.x * gridDim.y * gridDim.z;
    unsigned sum, cnt, mine, sp = 0u;
    for (;;) {
        sum = 0u; cnt = 0u; mine = 0u;
#pragma unroll
        for (unsigned j = 0; j < 16; ++j) { const unsigned c = xb_ld(&bar[XB_XCNT(j)]); sum += c; cnt += (c > 0u) ? 1u : 0u; mine = (j == x) ? c : mine; }
        if (sum == G) break;
        __builtin_amdgcn_s_sleep(1);
        if ((++sp & 255u) == 0u) { if (xb_ld(&bar[XB_TMO])) break; if (sp > XB_SPIN_CAP) { atomicAdd(&bar[XB_TMO], 1u); break; } }
    }
    nloc = mine > 0u ? mine : 1u; nx = cnt > 0u ? cnt : 1u;
}

__device__ __forceinline__ void xcd_barrier(const XcdBarrier& b) {
    asm volatile("s_waitcnt vmcnt(0)" ::: "memory");
    __syncthreads();
    int xb_t = TID_NOW(b.wv); asm volatile("" : "+v"(xb_t));
    if (xb_t == 0) {
        unsigned* bar = b.bar;
        __builtin_amdgcn_s_waitcnt(0);
        unsigned nloc = b.st[0], nx = b.st[1];
        if (nloc == 0u) { xcd_barrier_complete(bar, b.x, nloc, nx); b.st[0] = nloc; b.st[1] = nx; }
        const unsigned old = xb_add(&bar[XB_XSUB(b.x)], 1u);
        const unsigned gen = old / nloc;
        if (old + 1u == (gen + 1u) * nloc) {
            __builtin_amdgcn_fence(__ATOMIC_RELEASE, "agent");
            asm volatile("s_waitcnt vmcnt(0)" ::: "memory");
            const unsigned og = xb_add(&bar[XB_TOP], 1u);
            const unsigned tg = og / nx;
            if (og + 1u == (tg + 1u) * nx) xb_add(&bar[XB_TOPGEN], 1u);
            else XB_SPIN(xb_ld(&bar[XB_TOPGEN]) == tg, bar);
            __builtin_amdgcn_fence(__ATOMIC_ACQUIRE, "agent");
            xb_add(&bar[XB_XGEN(b.x)], 1u);
            asm volatile("s_waitcnt vmcnt(0)" ::: "memory");
        } else {
            XB_SPIN(xb_ld(&bar[XB_XGEN(b.x)]) == gen, bar);
            __builtin_amdgcn_fence(__ATOMIC_ACQUIRE, "agent");
            asm volatile("s_waitcnt vmcnt(0)" ::: "memory");
        }
    }
    __syncthreads();
}

#ifndef GEMM_MASK
#define GEMM_MASK 63
#endif
#define GEMM_CALL1 if ((GEMM_MASK >> 0) & 1)
#define GEMM_CALL2 if ((GEMM_MASK >> 1) & 1)
#define GEMM_CALL3 if ((GEMM_MASK >> 2) & 1)
#define GEMM_CALL4 if ((GEMM_MASK >> 3) & 1)
#define GEMM_CALL5 if ((GEMM_MASK >> 4) & 1)
#define GEMM_CALL6 if ((GEMM_MASK >> 5) & 1)
struct Args { const float* in[18]; float* out; unsigned char* ws; int ph_lo, ph_hi; };
constexpr int N_PHASES = 21;

__global__ void __launch_bounds__(512, 2) fwd_mega(Args args) {
    extern __shared__ __attribute__((aligned(16))) unsigned char lds[];
    cg::grid_group grid = cg::this_grid();
    Ctx C;
#pragma unroll
    for (int i = 0; i < 18; ++i) C.in[i] = args.in[i];
    C.out = args.out; C.ws = args.ws; C.lds = lds; C.G = gridDim.x; C.wv = __builtin_amdgcn_readfirstlane(threadIdx.x >> 6);
    PG8_LAS unsigned char* ldsg = (PG8_LAS unsigned char*)lds;
    volatile LAS unsigned* bst = (volatile LAS unsigned*)(ldsg + 131072);
    if (threadIdx.x < 64) bst[threadIdx.x] = 0u;
    __syncthreads();
    XcdBarrier xbar = xcd_barrier_post((unsigned*)(args.ws + 4096 * 4), bst);
    xbar.wv = C.wv;
    bf16_t* Wb = (bf16_t*)(C.ws + WS_W);
    bf16_t* XN = (bf16_t*)(C.ws + WS_XN);
    bf16_t* BIG = (bf16_t*)(C.ws + WS_BIG);
    if (args.ph_lo < 0) grid.sync();
    for (int ph = args.ph_lo; ph < args.ph_hi; ++ph) {
        if (ph == 0) {
#ifndef NO_P0
 p0_prologue(C);
#endif
 }
        else {
            const int l = (ph - 1) / 10, k = (ph - 1) % 10;
            if (k == 0) {
                __syncthreads();
                pg8::Gemm g{XN, Wb + OW_IN + (size_t)l * DIN * 1024, 1024, 1024, 1024, C.wv};
                pg8::StdSched S{128, 23, C.G, (int)blockIdx.x, (size_t)256 * 1024 * 2, (size_t)256 * 1024 * 2, WGM_BIG};
                EpiProj E{BIG, C.in[6] + l * 3072, lds};
                GEMM_CALL1 pg8::gemm_phase<EpiProj, pg8::StdSched, true, true>(ldsg, g, S, E);
#if defined(DUP_P1)
                __syncthreads(); pg8::gemm_phase<EpiProj, pg8::StdSched, true, true>(ldsg, g, S, E);
#endif
            } else if (k == 1) {
                __syncthreads();
#ifndef NO_P2
                p2_prep(C, l);
#endif
            } else if (k == 2) {
                __syncthreads();
#ifdef ECHO_SUB
#define ECHO_HERE(id) do { xcd_barrier(xbar); if (ECHO_SUB == (id)) { const unsigned long long e1 = __builtin_amdgcn_s_memrealtime(); while (__builtin_amdgcn_s_memrealtime() < e1 + (e1 - e0)) __builtin_amdgcn_s_sleep(8); } e0 = __builtin_amdgcn_s_memrealtime(); } while (0)
                unsigned long long e0 = __builtin_amdgcn_s_memrealtime();
#else
#define ECHO_HERE(id)
#endif
                p3_attn(C, l, 0);
                ECHO_HERE(1);
                p3_natten(C, l, 0);
                ECHO_HERE(2);
                __syncthreads();
                pg8::Gemm g{(const bf16_t*)(C.ws + WS_XN), Wb + OW_POOL + (size_t)l * 512 * 512, 512, 512, 512, C.wv};
                pg8::StdSched S{128, 2, C.G, (int)blockIdx.x, (size_t)256 * 512 * 2, (size_t)256 * 512 * 2, WGM_SMALL};
                EpiPlain E{BIG + C_POOL, DIN, lds};
                GEMM_CALL2 pg8::gemm_phase<EpiPlain, pg8::StdSched, true, true>(ldsg, g, S, E);
            } else if (k == 3) {
                __syncthreads();
                pg8::Gemm g{BIG, Wb + OW_BR + (size_t)l * 3 * 1024 * 512, DIN, 512, 512, C.wv};
                BranchSched S{C.G, (int)blockIdx.x};
                EpiBranch E{BIG, XN, lds};
                GEMM_CALL3 pg8::gemm_phase<EpiBranch, BranchSched, true, true>(ldsg, g, S, E);
            } else if (k == 4) {
                __syncthreads();
                pg8::Gemm g{XN, Wb + OW_OUT + (size_t)l * 1024 * 1024, 1024, 1024, 1024, C.wv};
                pg8::StdSched S{128, 4, C.G, (int)blockIdx.x, (size_t)256 * 1024 * 2, (size_t)256 * 1024 * 2, WGM_SMALL};
                EpiPlain E{BIG, DM, lds};
                GEMM_CALL4 pg8::gemm_phase<EpiPlain, pg8::StdSched, true, true>(ldsg, g, S, E);
            } else if (k == 5) {
                int tid_ = TID_NOW(C.wv); asm volatile("" : "+v"(tid_)); const int lane = tid_ & 63, gw = blockIdx.x * 8 + __builtin_amdgcn_readfirstlane(tid_ >> 6), NGW = C.G * 8;
                const float* xin = (l == 0) ? C.in[0] : C.out;
                for (int m = gw; m < NTOK; m += 2 * NGW)
                    resnorm_rows<2>(BIG + (size_t)m * DM, xin + (size_t)m * DM, C.in[2] + l * DM, C.out + (size_t)m * DM, C.in[3] + l * DM, XN + (size_t)m * DM, (size_t)NGW * DM, lane);
            } else if (k == 6) {
                __syncthreads();
                pg8::Gemm g{XN, Wb + OW_UP + (size_t)l * DUP * 1024, 1024, 1024, 1024, C.wv};
                pg8::StdSched S{128, 22, C.G, (int)blockIdx.x, (size_t)256 * 1024 * 2, (size_t)256 * 1024 * 2, WGM_BIG};
                EpiUp E{BIG, (bf16_t*)(C.ws + WS_VAT), lds};
                GEMM_CALL5 pg8::gemm_phase<EpiUp, pg8::StdSched, true, true>(ldsg, g, S, E);
            } else if (k == 7) {
#ifndef NO_P8
                p8_convact(C, l);
#endif
            } else if (k == 8) {
                __syncthreads();
                pg8::Gemm g{BIG, Wb + OW_DN + (size_t)l * 1024 * DFF, DUP, DFF, DFF, C.wv};
                pg8::StdSched S{128, 4, C.G, (int)blockIdx.x, (size_t)256 * DUP * 2, (size_t)256 * DFF * 2, WGM_SMALL};
                EpiPlain E{XN, DM, lds};
                GEMM_CALL6 pg8::gemm_phase<EpiPlain, pg8::StdSched, true, true>(ldsg, g, S, E);
            } else {
                int tid_ = TID_NOW(C.wv); asm volatile("" : "+v"(tid_)); const int lane = tid_ & 63, gw = blockIdx.x * 8 + __builtin_amdgcn_readfirstlane(tid_ >> 6), NGW = C.G * 8;
                const float* gnext = (l == 0) ? (C.in[1] + DM) : nullptr;
                for (int m = gw; m < NTOK; m += 2 * NGW)
                    resnorm_rows<2>(XN + (size_t)m * DM, C.out + (size_t)m * DM, C.in[4] + l * DM, C.out + (size_t)m * DM, gnext, XN + (size_t)m * DM, (size_t)NGW * DM, lane);
            }
        }
        if (ph + 1 < args.ph_hi) xcd_barrier(xbar);
    }
}

#ifndef MK_N_LAUNCHES
#define MK_N_LAUNCHES 1
#endif
extern "C" void kernel_launch(void* const* d_in, const int* in_sizes, int n_in, void* d_out, int out_size, void* d_ws, size_t ws_size, hipStream_t stream) {
    static int grid = 0;
    if (grid == 0) {
        if (n_in != 18 || out_size != NTOK * DM || ws_size < WS_END) { fprintf(stderr, "kernel_launch: unexpected shapes (n_in %d out %d ws %zu)\n", n_in, out_size, ws_size); grid = -1; return; }
        int dev = 0, cus = 0, per_cu = 0;
        hipGetDevice(&dev); hipDeviceGetAttribute(&cus, hipDeviceAttributeMultiprocessorCount, dev);
        if (hipFuncSetAttribute((const void*)fwd_mega, hipFuncAttributeMaxDynamicSharedMemorySize, LDS_BYTES) != hipSuccess) { fprintf(stderr, "kernel_launch: hipFuncSetAttribute failed\n"); grid = -1; return; }
        if (hipOccupancyMaxActiveBlocksPerMultiprocessor(&per_cu, (const void*)fwd_mega, 512, LDS_BYTES) != hipSuccess || per_cu < 1) { fprintf(stderr, "kernel_launch: occupancy query says %d\n", per_cu); per_cu = 1; }
        (void)hipGetLastError();
        grid = cus;
    }
    if (grid < 0) return;
    if (hipMemsetAsync(d_ws, 0, 1 << 20, stream) != hipSuccess) { fprintf(stderr, "kernel_launch: memset failed\n"); return; }
    Args a{};
    for (int i = 0; i < 18; ++i) a.in[i] = (const float*)d_in[i];
    a.out = (float*)d_out; a.ws = (unsigned char*)d_ws;
    if (MK_N_LAUNCHES == 1) {
        a.ph_lo = 0; a.ph_hi = N_PHASES;
        void* kargs[] = {&a};
        hipError_t e = hipLaunchCooperativeKernel((const void*)fwd_mega, dim3(grid), dim3(512), kargs, LDS_BYTES, stream);
        if (e != hipSuccess) fprintf(stderr, "cooperative launch failed: %s (grid %d)\n", hipGetErrorString(e), grid);
    } else {
        for (int ph = 0; ph < N_PHASES; ++ph) { a.ph_lo = ph; a.ph_hi = ph + 1; hipLaunchKernelGGL(fwd_mega, dim3(grid), dim3(512), LDS_BYTES, stream, a); }
    }
}
```
